# Optimizing an MI355X kernel written in HIP

```python
import math
import jax, jax.numpy as jnp
from jax import lax
import numpy as np

D_MODEL = 1024
BATCH = 4
SEQ = 8192
DEPTH = 1

HEAD_DIM = 64
A_HEADS = 8
A_KV_HEADS = 2
A_GROUP = A_HEADS // A_KV_HEADS
B_HEADS = 8
A_Q_W = A_HEADS * HEAD_DIM
A_KV_W = A_KV_HEADS * HEAD_DIM
B_W = B_HEADS * HEAD_DIM
MIX_W = A_Q_W + B_W
D_IN = A_Q_W + 2 * A_KV_W + 3 * B_W
WINDOW = 128
BLK = 128
ROPE_THETA = 500000.0
ROT_DIM = HEAD_DIM // 4
GRID_W = 64
NA_KH = 8
NA_KW = 16
D_FF = 2816
CONV_W = 3
EPS = 1e-6

kernel_name = "hybrid_window_gqa_neighbourhood_convffn"


def rmsnorm(x, g):
    xf = x.astype(jnp.float32)
    y = xf * lax.rsqrt(jnp.mean(xf * xf, axis=-1, keepdims=True) + EPS)
    return (y * g.astype(jnp.float32)).astype(x.dtype)


def partial_rope(t, cos, sin):
    half = ROT_DIM // 2
    x1 = t[..., :half]
    x2 = t[..., half:ROT_DIM]
    return jnp.concatenate([x1 * cos - x2 * sin, x2 * cos + x1 * sin, t[..., ROT_DIM:]], axis=-1)


def window_gqa_sink(q, k, v, sink):
    B, S = q.shape[0], q.shape[1]
    nb = S // BLK
    span = BLK + 2 * WINDOW
    scale = 1.0 / math.sqrt(HEAD_DIM)
    qb = q.reshape(B, nb, BLK, A_KV_HEADS, A_GROUP, HEAD_DIM)
    qb = jnp.moveaxis(qb, 1, 0)
    pad = ((0, 0), (WINDOW, WINDOW), (0, 0), (0, 0))
    kp = jnp.pad(k, pad)
    vp = jnp.pad(v, pad)
    sink_gr = sink.astype(jnp.float32).reshape(A_KV_HEADS, A_GROUP)[None, :, :, None]

    def block(args):
        q_i, i = args
        start = i * BLK
        k_i = lax.dynamic_slice_in_dim(kp, start, span, axis=1)
        v_i = lax.dynamic_slice_in_dim(vp, start, span, axis=1)
        s = jnp.einsum('bqgrd,bkgd->bgrqk', q_i, k_i).astype(jnp.float32) * scale
        qpos = i * BLK + jnp.arange(BLK)
        kpos = i * BLK - WINDOW + jnp.arange(span)
        valid = (jnp.abs(qpos[:, None] - kpos[None, :]) <= WINDOW) & (kpos[None, :] >= 0) & (kpos[None, :] < S)
        s = jnp.where(valid[None, None, None], s, -1e30)
        m = jnp.maximum(jnp.max(s, axis=-1), sink_gr)
        p = jnp.exp(s - m[..., None])
        denom = jnp.sum(p, axis=-1) + jnp.exp(sink_gr - m)
        o = jnp.einsum('bgrqk,bkgd->bgrqd', p.astype(v_i.dtype), v_i)
        o = o / denom[..., None].astype(o.dtype)
        return jnp.transpose(o, (0, 3, 1, 2, 4))

    out = lax.map(block, (qb, jnp.arange(nb, dtype=jnp.int32)))
    out = jnp.moveaxis(out, 0, 1)
    return out.reshape(B, S, A_Q_W)


def neighbourhood_attention(q, k, v, rpb):
    B, S = q.shape[0], q.shape[1]
    rows = S // GRID_W
    kh = min(NA_KH, rows)
    scale = 1.0 / math.sqrt(HEAD_DIM)
    cs = np.clip(np.arange(GRID_W) - NA_KW // 2, 0, GRID_W - NA_KW)
    col_idx = cs[:, None] + np.arange(NA_KW)[None, :]
    col_off = col_idx - np.arange(GRID_W)[:, None] + (NA_KW - 1)
    qg = jnp.moveaxis(q.reshape(B, rows, GRID_W, B_HEADS, HEAD_DIM), 1, 0)
    kg = k.reshape(B, rows, GRID_W, B_HEADS, HEAD_DIM)
    vg = v.reshape(B, rows, GRID_W, B_HEADS, HEAD_DIM)
    rpb32 = rpb.astype(jnp.float32)

    def row(args):
        q_r, r = args
        rs = jnp.clip(r - kh // 2, 0, rows - kh)
        k_rows = lax.dynamic_slice_in_dim(kg, rs, kh, axis=1)
        v_rows = lax.dynamic_slice_in_dim(vg, rs, kh, axis=1)
        k_win = k_rows[:, :, col_idx]
        v_win = v_rows[:, :, col_idx]
        row_off = rs + jnp.arange(kh) - r + (NA_KH - 1)
        bias = rpb32[:, row_off][:, :, col_off]
        bias = jnp.transpose(bias, (0, 2, 1, 3))
        s = jnp.einsum('bchd,bicjhd->bhcij', q_r, k_win).astype(jnp.float32) * scale + bias[None]
        p = jax.nn.softmax(s.reshape(B, B_HEADS, GRID_W, kh * NA_KW), axis=-1)
        p = p.reshape(B, B_HEADS, GRID_W, kh, NA_KW).astype(v_win.dtype)
        return jnp.einsum('bhcij,bicjhd->bchd', p, v_win)

    out = lax.map(row, (qg, jnp.arange(rows, dtype=jnp.int32)))
    out = jnp.moveaxis(out, 0, 1)
    return out.reshape(B, S, B_W)


def conv_gated_mlp(h, w_gate, w_up, conv_w, conv_b, w_down):
    g = jnp.einsum('bsd,df->bsf', h, w_gate)
    u = jnp.einsum('bsd,df->bsf', h, w_up)
    g = lax.conv_general_dilated(
        g, conv_w[:, None, :], window_strides=(1,),
        padding=((CONV_W // 2, CONV_W // 2),),
        dimension_numbers=('NWC', 'WIO', 'NWC'),
        feature_group_count=D_FF) + conv_b
    return jnp.einsum('bsf,fd->bsd', jax.nn.silu(g) * u, w_down)


def setup_inputs(seed: int = 0) -> dict:
    key = jax.random.key(seed)
    ks = jax.random.split(key, 16)
    f32 = jnp.float32
    nrm = lambda k, shape, s: jax.random.normal(k, shape, f32) * s
    return {
        "x": jax.random.normal(ks[0], (BATCH, SEQ, D_MODEL), f32),
        "norm_mix": 1.0 + nrm(ks[1], (DEPTH, D_MODEL), 0.02),
        "w_in": nrm(ks[2], (DEPTH, D_MODEL, D_IN), D_MODEL ** -0.5),
        "sink": nrm(ks[3], (DEPTH, A_HEADS), 0.5),
        "rpb": nrm(ks[4], (DEPTH, B_HEADS, 2 * NA_KH - 1, 2 * NA_KW - 1), 0.1),
        "norm_a": 1.0 + nrm(ks[5], (DEPTH, A_Q_W), 0.02),
        "norm_b": 1.0 + nrm(ks[6], (DEPTH, B_W), 0.02),
        "w_out": nrm(ks[7], (DEPTH, MIX_W, D_MODEL), MIX_W ** -0.5),
        "norm_ffn": 1.0 + nrm(ks[8], (DEPTH, D_MODEL), 0.02),
        "w_gate": nrm(ks[9], (DEPTH, D_MODEL, D_FF), D_MODEL ** -0.5),
        "w_up": nrm(ks[10], (DEPTH, D_MODEL, D_FF), D_MODEL ** -0.5),
        "conv_w": nrm(ks[11], (DEPTH, CONV_W, D_FF), CONV_W ** -0.5),
        "conv_b": nrm(ks[12], (DEPTH, D_FF), 0.02),
        "w_down": nrm(ks[13], (DEPTH, D_FF, D_MODEL), D_FF ** -0.5),
        "norm_final": 1.0 + nrm(ks[14], (D_MODEL,), 0.02),
    }


def reference(x, norm_mix, w_in, sink, rpb, norm_a, norm_b, w_out, norm_ffn,
              w_gate, w_up, conv_w, conv_b, w_down, norm_final):
    B, S = x.shape[0], x.shape[1]
    pos = jnp.arange(S, dtype=jnp.float32)
    inv_freq = ROPE_THETA ** (-jnp.arange(0, ROT_DIM, 2, dtype=jnp.float32) / ROT_DIM)
    ang = pos[:, None] * inv_freq[None, :]
    cos = jnp.cos(ang)[:, None, :].astype(x.dtype)
    sin = jnp.sin(ang)[:, None, :].astype(x.dtype)
    splits = np.cumsum([A_Q_W, A_KV_W, A_KV_W, B_W, B_W]).tolist()
    h = x
    for l in range(DEPTH):
        hn = rmsnorm(h, norm_mix[l])
        proj = jnp.einsum('bsd,de->bse', hn, w_in[l])
        qa, ka, va, qb, kb, vb = jnp.split(proj, splits, axis=-1)
        qa = partial_rope(qa.reshape(B, S, A_HEADS, HEAD_DIM), cos, sin)
        ka = partial_rope(ka.reshape(B, S, A_KV_HEADS, HEAD_DIM), cos, sin)
        va = va.reshape(B, S, A_KV_HEADS, HEAD_DIM)
        o_a = window_gqa_sink(qa, ka, va, sink[l])
        o_b = neighbourhood_attention(
            qb.reshape(B, S, B_HEADS, HEAD_DIM),
            kb.reshape(B, S, B_HEADS, HEAD_DIM),
            vb.reshape(B, S, B_HEADS, HEAD_DIM), rpb[l])
        mix = jnp.concatenate([rmsnorm(o_a, norm_a[l]), rmsnorm(o_b, norm_b[l])], axis=-1)
        h = h + jnp.einsum('bse,ed->bsd', mix, w_out[l])
        hn = rmsnorm(h, norm_ffn[l])
        h = h + conv_gated_mlp(hn, w_gate[l], w_up[l], conv_w[l], conv_b[l], w_down[l])
    return rmsnorm(h, norm_final)
```

```cpp
#include <hip/hip_runtime.h>
#include <hip/hip_cooperative_groups.h>
#include <cstdio>
#include <cstdint>
#include <cmath>
namespace cg = cooperative_groups;
namespace pg8 {
#define PG8_LAS __attribute__((address_space(3)))
typedef unsigned short bf16_t;
typedef short bf16x8 __attribute__((ext_vector_type(8)));
typedef float f32x4 __attribute__((ext_vector_type(4)));
typedef unsigned u32x4 __attribute__((ext_vector_type(4)));
constexpr int BM = 256, BK = 64, HALF = 128, HTB = HALF * BK * 2  , STAGE_BYTES = 8 * HTB, NXCD = 8, WGM = 8;

__host__ __device__ __forceinline__ int lds_byte(int r, int c) { const int st = (r >> 4) * 2 + (c >> 5), rr = r & 15, cc = c & 31, ob = rr * 64 + cc * 2; return st * 1024 + (ob ^ (((ob >> 9) & 1) << 5)); }
__host__ __device__ __forceinline__ void stage_rc(int b, int& R, int& C) { const int st = b / 1024, sb = b % 1024, swz = sb ^ (((sb >> 9) & 1) << 5); R = (st >> 1) * 16 + swz / 64; C = (st & 1) * 32 + (swz % 64) / 2; }
__host__ __device__ __forceinline__ int perm32(int rho) { const int n = rho >> 4, i = rho & 15; return 8 * (i >> 2) + 4 * n + (i & 3); }

struct Unit { int pm, pn, ord; };
struct Gemm { const bf16_t* A; const bf16_t* Bt; int M, N, K; };

struct StaticOrder {
    int nM, nN, nwg, G, c;
    __host__ __device__ __forceinline__ void init(int M, int N, int G_, int c_) { nM = M / BM; nN = N / BM; nwg = nM * nN; G = G_; c = c_; }
    __host__ __device__ __forceinline__ bool next(int i, Unit& u) const {
        const long L = (long)i * G + c; if (L >= nwg) return false;
        int wgid = (int)L; { const int q = nwg / NXCD, r = nwg % NXCD, xcd = wgid % NXCD, off = wgid / NXCD; wgid = (xcd < r ? xcd * (q + 1) : r * (q + 1) + (xcd - r) * q) + off; }
        const int nig = WGM * nN, gid = wgid / nig, fm = gid * WGM, gsz = (nM - fm) < WGM ? (nM - fm) : WGM;
        u.pm = fm + ((wgid % nig) % gsz); u.pn = (wgid % nig) / gsz; return true;
    }
    __device__ __forceinline__ void a_ready(const Unit&) const {}
    __device__ __forceinline__ void done(const Unit&) const {}
};
__device__ __forceinline__ unsigned cvt_pk_bf16(float lo, float hi) { unsigned r; asm volatile("v_cvt_pk_bf16_f32 %0, %1, %2" : "=v"(r) : "v"(lo), "v"(hi)); return r; }
typedef float f32x2 __attribute__((ext_vector_type(2)));
template <class Epi, class Sched, bool ALIGN_EPI = false, bool SP2 = false>
__device__ __forceinline__ void gemm_phase(PG8_LAS unsigned char* lds, const Gemm g, const Sched& S, const Epi& E) {
    const int tid = threadIdx.x, wid = __builtin_amdgcn_readfirstlane(tid >> 6), lane = tid & 63, wr = wid >> 2, wc = wid & 3, fr = lane & 15, fq = lane >> 4;
    const int K = g.K, nt = K / BK;
    unsigned voffA[2], voffB[2];
#pragma unroll
    for (int i = 0; i < 2; ++i) { int R, C; stage_rc(tid * 16 + i * 8192, R, C); const int Rb = Epi::PERM ? ((R & ~31) + perm32(R & 31)) : R;
        voffA[i] = (unsigned)(R * K + C) * 2u; voffB[i] = (unsigned)(Rb * K + C) * 2u; }
    const size_t kstep = (size_t)(BK * 2);
    const size_t hstep = (size_t)HALF * K * 2;
    const size_t tstep = 2 * hstep;
    const unsigned ldsw = (unsigned)wid * 1024u;
    const int aoff = lds_byte(wr * 64 + fr, fq * 8), boff = lds_byte(wc * 32 + fr, fq * 8);
#define PG8_SA(b, h) (((b) * 2 + (h)) * HTB)
#define PG8_SB(b, h) ((4 + (b) * 2 + (h)) * HTB)
#define PG8_STAGE(bufoff, gbase, voff) do { _Pragma("unroll") for (int _i = 0; _i < 2; ++_i) \
        __builtin_amdgcn_global_load_lds((const unsigned*)((const char*)(gbase) + (voff)[_i]), (PG8_LAS unsigned*)(lds + (bufoff) + ldsw + _i * 8192), 16, 0, 0); } while (0)
#define PG8_LDA(dst, b, h) do { _Pragma("unroll") for (int m = 0; m < 4; ++m) _Pragma("unroll") for (int k = 0; k < 2; ++k) dst[m][k] = *(const PG8_LAS bf16x8*)(lds + PG8_SA(b, h) + aoff + m * 2048 + k * 1024); } while (0)
#define PG8_LDB(dst, b, h) do { _Pragma("unroll") for (int n = 0; n < 2; ++n) _Pragma("unroll") for (int k = 0; k < 2; ++k) dst[n][k] = *(const PG8_LAS bf16x8*)(lds + PG8_SB(b, h) + boff + n * 2048 + k * 1024); } while (0)
#define PG8_MMA(ai, bj, At, Bt) do { __builtin_amdgcn_s_setprio(1); _Pragma("unroll") for (int m = 0; m < 4; ++m) _Pragma("unroll") for (int n = 0; n < 2; ++n) _Pragma("unroll") for (int k = 0; k < 2; ++k) \
        acc[ai][bj][m][n] = __builtin_amdgcn_mfma_f32_16x16x32_bf16(Bt[n][k], At[m][k], acc[ai][bj][m][n], 0, 0, 0); __builtin_amdgcn_s_setprio(0); } while (0)
#define PG8_WAIT_V(n) asm volatile("s_waitcnt vmcnt(" #n ")" ::: "memory")
#define PG8_WAIT_L(n) asm volatile("s_waitcnt lgkmcnt(" #n ")" ::: "memory")
#define PG8_BAR __builtin_amdgcn_s_barrier()
#define PG8_SCHED __builtin_amdgcn_sched_barrier(0)
    Unit cur, nxt; int ui = 0;
    if (!S.next(0, cur)) return;
    f32x4 acc[2][2][4][2];
#pragma unroll
    for (int a = 0; a < 2; ++a)
#pragma unroll
        for (int b = 0; b < 2; ++b)
#pragma unroll
            for (int m = 0; m < 4; ++m)
#pragma unroll
                for (int n = 0; n < 2; ++n) acc[a][b][m][n] = (f32x4){0.f, 0.f, 0.f, 0.f};
    bf16x8 At[4][2], B0[2][2], B1[2][2];
    const char* cA = (const char*)g.A + (size_t)cur.pm * tstep; const char* cB = (const char*)g.Bt + (size_t)cur.pn * tstep;
    S.a_ready(cur);
    if constexpr (SP2) {
        PG8_STAGE(PG8_SB(0, 0), cB, voffB); PG8_STAGE(PG8_SB(0, 1), cB + hstep, voffB); PG8_STAGE(PG8_SA(0, 0), cA, voffA); PG8_STAGE(PG8_SA(0, 1), cA + hstep, voffA);
        if (wr == 1) PG8_BAR;
        PG8_WAIT_V(2); PG8_BAR;
        PG8_STAGE(PG8_SB(1, 0), cB + kstep, voffB); PG8_STAGE(PG8_SA(1, 0), cA + kstep, voffA); PG8_STAGE(PG8_SB(1, 1), cB + hstep + kstep, voffB);
        PG8_WAIT_V(6); PG8_BAR;
    } else {
        PG8_STAGE(PG8_SB(0, 0), cB, voffB); PG8_STAGE(PG8_SA(0, 0), cA, voffA); PG8_STAGE(PG8_SB(0, 1), cB + hstep, voffB); PG8_STAGE(PG8_SA(0, 1), cA + hstep, voffA);
        if (wr == 1) PG8_BAR;
        PG8_WAIT_V(4); PG8_BAR;
        PG8_STAGE(PG8_SB(1, 0), cB + kstep, voffB); PG8_STAGE(PG8_SA(1, 0), cA + kstep, voffA); PG8_STAGE(PG8_SB(1, 1), cB + hstep + kstep, voffB);
        PG8_WAIT_V(6); PG8_BAR;
    }
    for (;;) {
        const bool has_next = S.next(ui + 1, nxt);
        const char* nA = has_next ? (const char*)g.A + (size_t)nxt.pm * tstep : cA; const char* nB = has_next ? (const char*)g.Bt + (size_t)nxt.pn * tstep : cB;
        for (int t = 0; t < nt; t += 2) {
            const bool last = (t == nt - 2);
            const char* a1 = cA + (size_t)(t + 1) * kstep;
            const char* a2 = last ? nA : cA + (size_t)(t + 2) * kstep; const char* b2 = last ? nB : cB + (size_t)(t + 2) * kstep;
            const char* a3 = a2 + kstep; const char* b3 = b2 + kstep;
            if (last && has_next) S.a_ready(nxt);
            if constexpr (SP2) {
            PG8_LDB(B0, 0, 0); PG8_LDB(B1, 0, 1); PG8_SCHED; PG8_LDA(At, 0, 0); PG8_STAGE(PG8_SA(1, 1), a1 + hstep, voffA);
            PG8_WAIT_V(8); PG8_WAIT_L(0); PG8_BAR; PG8_MMA(0, 0, At, B0); PG8_MMA(0, 1, At, B1); PG8_BAR; PG8_SCHED;
            PG8_LDA(At, 0, 1); PG8_STAGE(PG8_SB(0, 0), b2, voffB); PG8_STAGE(PG8_SB(0, 1), b2 + hstep, voffB); PG8_STAGE(PG8_SA(0, 0), a2, voffA);
            PG8_WAIT_V(8); PG8_WAIT_L(0); PG8_BAR; PG8_MMA(1, 0, At, B0); PG8_MMA(1, 1, At, B1); PG8_BAR; PG8_SCHED;
            PG8_LDB(B0, 1, 0); PG8_LDB(B1, 1, 1); PG8_SCHED; PG8_LDA(At, 1, 0); PG8_STAGE(PG8_SA(0, 1), a2 + hstep, voffA);
            PG8_WAIT_V(8); PG8_WAIT_L(0); PG8_BAR; PG8_MMA(0, 0, At, B0); PG8_MMA(0, 1, At, B1); PG8_BAR; PG8_SCHED;
            PG8_LDA(At, 1, 1); PG8_STAGE(PG8_SB(1, 0), b3, voffB); PG8_STAGE(PG8_SB(1, 1), b3 + hstep, voffB); PG8_STAGE(PG8_SA(1, 0), a3, voffA);
            PG8_WAIT_V(8); PG8_WAIT_L(0); PG8_BAR; PG8_MMA(1, 0, At, B0); PG8_MMA(1, 1, At, B1); PG8_BAR; PG8_SCHED;
            } else {
            PG8_LDB(B0, 0, 0); PG8_SCHED; PG8_LDA(At, 0, 0); PG8_STAGE(PG8_SA(1, 1), a1 + hstep, voffA);
            PG8_WAIT_L(8); PG8_BAR; PG8_WAIT_L(0); PG8_MMA(0, 0, At, B0); PG8_BAR; PG8_SCHED;
            PG8_LDB(B1, 0, 1); PG8_STAGE(PG8_SB(0, 0), b2, voffB);
            PG8_BAR; PG8_WAIT_L(0); PG8_MMA(0, 1, At, B1); PG8_BAR;
            PG8_LDA(At, 0, 1); PG8_STAGE(PG8_SA(0, 0), a2, voffA);
            PG8_BAR; PG8_WAIT_L(0); PG8_MMA(1, 0, At, B0); PG8_BAR; PG8_SCHED;
            PG8_STAGE(PG8_SB(0, 1), b2 + hstep, voffB);
            PG8_WAIT_V(6); PG8_BAR; PG8_MMA(1, 1, At, B1); PG8_BAR;
            PG8_LDB(B0, 1, 0); PG8_SCHED; PG8_LDA(At, 1, 0); PG8_STAGE(PG8_SA(0, 1), a2 + hstep, voffA);
            PG8_WAIT_L(8); PG8_BAR; PG8_WAIT_L(0); PG8_MMA(0, 0, At, B0); PG8_BAR; PG8_SCHED;
            PG8_LDB(B1, 1, 1); PG8_STAGE(PG8_SB(1, 0), b3, voffB);
            PG8_BAR; PG8_WAIT_L(0); PG8_MMA(0, 1, At, B1); PG8_BAR;
            PG8_LDA(At, 1, 1); PG8_STAGE(PG8_SA(1, 0), a3, voffA);
            PG8_BAR; PG8_WAIT_L(0); PG8_MMA(1, 0, At, B0); PG8_BAR; PG8_SCHED;
            PG8_STAGE(PG8_SB(1, 1), b3 + hstep, voffB);
            PG8_WAIT_V(6); PG8_BAR; PG8_MMA(1, 1, At, B1); PG8_BAR;
            }
        }
        if constexpr (ALIGN_EPI) { if (wr == 0) PG8_BAR; }
        if constexpr (!Epi::AFTER_DRAIN) { E(acc, cur, wr, wc, fr, fq); S.done(cur); }
        if (!has_next) break;
#pragma unroll
        for (int a = 0; a < 2; ++a)
#pragma unroll
            for (int b = 0; b < 2; ++b)
#pragma unroll
                for (int m = 0; m < 4; ++m)
#pragma unroll
                    for (int n = 0; n < 2; ++n) acc[a][b][m][n] = (f32x4){0.f, 0.f, 0.f, 0.f};
        cur = nxt; cA = nA; cB = nB; ++ui;
        if constexpr (ALIGN_EPI) { if (wr == 1) PG8_BAR; }
    }
    PG8_WAIT_V(0);
    if constexpr (!ALIGN_EPI) { if (wr == 0) PG8_BAR; }
    PG8_BAR;
    if constexpr (Epi::AFTER_DRAIN) { E.fused(acc, cur, wr, wc, fr, fq, lds, wid, lane); S.done(cur); }
#undef PG8_SA
#undef PG8_SB
#undef PG8_STAGE
#undef PG8_LDA
#undef PG8_LDB
#undef PG8_MMA
#undef PG8_WAIT_V
#undef PG8_WAIT_L
#undef PG8_BAR
#undef PG8_SCHED
}
}

#ifndef MK_N_LAUNCHES
#define MK_N_LAUNCHES 1
#endif
#define DI __device__ __forceinline__
#define LAS __attribute__((address_space(3)))
typedef unsigned short bf16_t;
typedef short bf16x8 __attribute__((ext_vector_type(8)));
typedef float f32x4 __attribute__((ext_vector_type(4)));
typedef float f32x16 __attribute__((ext_vector_type(16)));
typedef unsigned u32x4 __attribute__((ext_vector_type(4)));
typedef unsigned u32x2 __attribute__((ext_vector_type(2)));
typedef float f32x2_t __attribute__((ext_vector_type(2)));
typedef __bf16 bf16x2_t __attribute__((ext_vector_type(2)));

constexpr int DM = 1024, NBATCH = 4, SEQ = 8192, MROWS = NBATCH * SEQ, DIN = 2304, DFF = 2816, NGU = 2 * DFF;
constexpr float EPS = 1e-6f, LOG2E = 1.4426950408889634f, QSCALE = 0.125f * LOG2E;
constexpr int NPHASE = 6;
constexpr int NTHREADS = 512, NWAVES = 8;
constexpr int LDS_BYTES = 147456;

constexpr size_t MiB = 1u << 20;
constexpr size_t WS_WIN = 0, WS_WOUT = 5 * MiB, WS_WGU = 7 * MiB, WS_WDN = 18 * MiB, WS_ROPE = 24 * MiB, WS_SSQ1 = 25 * MiB, WS_SSQ2 = 27 * MiB;
constexpr size_t WS_GB = 29 * MiB, WS_UB = 51 * MiB;
constexpr size_t WS_XN = 64 * MiB, WS_MIX = 64 * MiB;
constexpr size_t WS_H1B = 128 * MiB;
constexpr size_t WS_QA = 192 * MiB, WS_KA = 224 * MiB, WS_VTA = 232 * MiB, WS_QB = 240 * MiB, WS_KB = 272 * MiB, WS_VTB = 304 * MiB;
constexpr size_t WS_ACT = 336 * MiB;
constexpr size_t WS_END = 512 * MiB;
static_assert(WS_ACT + (size_t)MROWS * DFF * 2 <= WS_END, "workspace map");
constexpr size_t WS_BAR = 24 * MiB + 768 * 1024;

DI unsigned cvtpk(float lo, float hi) { f32x2_t v = {lo, hi}; bf16x2_t b = __builtin_convertvector(v, bf16x2_t); return __builtin_bit_cast(unsigned, b); }
DI float wave_sum(float v) {
#pragma unroll
    for (int o = 1; o < 64; o <<= 1) v += __shfl_xor(v, o);
    return v;
}
DI float fexp2(float x) { return __builtin_amdgcn_exp2f(x); }
typedef __amdgpu_buffer_rsrc_t rsrc_t;
DI rsrc_t mk_rsrc(const void* base) { return __builtin_amdgcn_make_buffer_rsrc((void*)base, 0, 0x7ffffff0, 0x00020000); }
DI void st16_wt(rsrc_t r, unsigned byte_off, u32x4 v) { __builtin_amdgcn_raw_buffer_store_b128(v, r, (int)byte_off, 0, 16); }
template <int CTRL> DI float dpp_ror(float v) { return __builtin_bit_cast(float, __builtin_amdgcn_update_dpp(0, __builtin_bit_cast(int, v), CTRL, 0xf, 0xf, false)); }

#define XB_TMO      128
#define XB_XCNT(j)  (256  + 64 * (j))
#define XB_XSUB(j)  (1280 + 64 * (j))
#define XB_XGEN(j)  (2304 + 64 * (j))
#define XB_TOP      3328
#define XB_TOPGEN   3392
#define XCD_BAR_WORDS 3456
#define XB_SPIN_CAP (1u << 18)

__device__ __forceinline__ unsigned xb_ld(unsigned* p)              { return __hip_atomic_load(p, __ATOMIC_RELAXED, __HIP_MEMORY_SCOPE_AGENT); }
__device__ __forceinline__ unsigned xb_add(unsigned* p, unsigned v) { return __hip_atomic_fetch_add(p, v, __ATOMIC_RELAXED, __HIP_MEMORY_SCOPE_AGENT); }
__device__ __forceinline__ unsigned xb_xcc_id() { return (unsigned)__builtin_amdgcn_s_getreg((3 << 11) | 20) & 0xFu; }
#define XB_SPIN(cond, bar) do { unsigned _sp = 0; while (cond) { __builtin_amdgcn_s_sleep(1); \
    if ((++_sp & 255u) == 0u) { if (xb_ld(&(bar)[XB_TMO])) break; if (_sp > XB_SPIN_CAP) { atomicAdd(&(bar)[XB_TMO], 1u); break; } } } } while (0)

struct XcdBarrier {
    unsigned* bar; unsigned x;
    volatile LAS unsigned* st;
};

__device__ __forceinline__ XcdBarrier xcd_barrier_post(unsigned* bar, volatile LAS unsigned* st) {
    XcdBarrier b; b.bar = bar; b.x = xb_xcc_id(); b.st = st;
    if (threadIdx.x == 0) (void)xb_add(&bar[XB_XCNT(b.x)], 1u);
    return b;
}
__device__ __forceinline__ void xcd_barrier_complete(unsigned* bar, unsigned x, unsigned& nloc, unsigned& nx) {
    const unsigned G = gridDim.x * gridDim.y * gridDim.z;
    unsigned sum, cnt, mine, sp = 0u;
    for (;;) {
        sum = 0u; cnt = 0u; mine = 0u;
#pragma unroll
        for (unsigned j = 0; j < 16; ++j) { const unsigned c = xb_ld(&bar[XB_XCNT(j)]); sum += c; cnt += (c > 0u) ? 1u : 0u; mine = (j == x) ? c : mine; }
        if (sum == G) break;
        __builtin_amdgcn_s_sleep(1);
        if ((++sp & 255u) == 0u) { if (xb_ld(&bar[XB_TMO])) break; if (sp > XB_SPIN_CAP) { atomicAdd(&bar[XB_TMO], 1u); break; } }
    }
    nloc = mine > 0u ? mine : 1u; nx = cnt > 0u ? cnt : 1u;
}

__device__ __forceinline__ void xcd_barrier(const XcdBarrier& b) {
    asm volatile("s_waitcnt vmcnt(0)" ::: "memory");
    __syncthreads();
    if (threadIdx.x == 0) {
        unsigned* bar = b.bar;
        __builtin_amdgcn_s_waitcnt(0);
        unsigned nloc = b.st[0], nx = b.st[1];
        if (nloc == 0u) { xcd_barrier_complete(bar, b.x, nloc, nx); b.st[0] = nloc; b.st[1] = nx; }
        const unsigned old = xb_add(&bar[XB_XSUB(b.x)], 1u);
        const unsigned gen = old / nloc;
        if (old + 1u == (gen + 1u) * nloc) {
            __builtin_amdgcn_fence(__ATOMIC_RELEASE, "agent");
            asm volatile("s_waitcnt vmcnt(0)" ::: "memory");
            const unsigned og = xb_add(&bar[XB_TOP], 1u);
            const unsigned tg = og / nx;
            if (og + 1u == (tg + 1u) * nx) xb_add(&bar[XB_TOPGEN], 1u);
            else XB_SPIN(xb_ld(&bar[XB_TOPGEN]) == tg, bar);
            __builtin_amdgcn_fence(__ATOMIC_ACQUIRE, "agent");
            xb_add(&bar[XB_XGEN(b.x)], 1u);
            asm volatile("s_waitcnt vmcnt(0)" ::: "memory");
        } else {
            XB_SPIN(xb_ld(&bar[XB_XGEN(b.x)]) == gen, bar);
            __builtin_amdgcn_fence(__ATOMIC_ACQUIRE, "agent");
            asm volatile("s_waitcnt vmcnt(0)" ::: "memory");
        }
    }
    __syncthreads();
}


template <int MODE, bool WT_THROUGH = false>
DI void p0_transpose_item(const float* __restrict__ W, int K, int N, bf16_t* __restrict__ WT, LAS float* scr, int item, int lane, const float* __restrict__ ks) {
    const int nblk = N / 32, kb = item / nblk, nb = item % nblk, k0 = 64 * kb, n0 = 32 * nb;
#pragma unroll 8
    for (int i = 0; i < 32; ++i) { const int kk = 2 * i + (lane >> 5); float v = W[(size_t)(k0 + kk) * N + n0 + (lane & 31)]; if (MODE != 0) v *= ks[k0 + kk]; scr[kk * 33 + (lane & 31)] = v; }
    asm volatile("s_waitcnt lgkmcnt(0)" ::: "memory");
    const int c = lane & 7;
    const int rbase = (MODE == 0) ? n0 : (256 * (n0 >> 7) + (n0 & 127) + (MODE == 2 ? 128 : 0));
#pragma unroll
    for (int j = 0; j < 4; ++j) { const int n = (lane >> 3) + 8 * j; const LAS float* s = scr + (8 * c) * 33 + n;
        u32x4 o; o.x = cvtpk(s[0 * 33], s[1 * 33]); o.y = cvtpk(s[2 * 33], s[3 * 33]); o.z = cvtpk(s[4 * 33], s[5 * 33]); o.w = cvtpk(s[6 * 33], s[7 * 33]);
        if (MODE == 0 && !WT_THROUGH) *(u32x4*)(WT + (size_t)(rbase + n) * K + k0 + 8 * c) = o;
        else st16_wt(mk_rsrc(WT), (unsigned)(((rbase + n) * K + k0 + 8 * c) * 2), o); }
    asm volatile("s_waitcnt lgkmcnt(0)" ::: "memory");
}

struct Ptrs {
    const float *x, *norm_mix, *w_in, *sink, *rpb, *norm_a, *norm_b, *w_out, *norm_ffn, *w_gate, *w_up, *conv_w, *conv_b, *w_down, *norm_final;
    float* out; unsigned char* ws;
};

DI void phase0_local(const Ptrs& P, LAS unsigned char* lds, int vcu, int G, int wave, int lane, int tid, unsigned* wcnt) {
    LAS float* scr = (LAS float*)(lds + wave * 16384);
    const int gw = vcu * NWAVES + wave, NGW = G * NWAVES;
    bf16_t* WIN = (bf16_t*)(P.ws + WS_WIN); bf16_t* WOUT = (bf16_t*)(P.ws + WS_WOUT);
    constexpr int I_IN = (DM / 64) * (DIN / 32), I_OUT = (DM / 64) * (DM / 32);
    for (int it = gw; it < I_IN + I_OUT; it += NGW) {
        int r = it;
        if (r < I_IN) { p0_transpose_item<0, true>(P.w_in, DM, DIN, WIN, scr, r, lane, nullptr); continue; } r -= I_IN;
        p0_transpose_item<0, true>(P.w_out, DM, DM, WOUT, scr, r, lane, nullptr);
    }
    float* rope = (float*)(P.ws + WS_ROPE);
    for (int idx = vcu * NTHREADS + tid; idx < SEQ * 8; idx += G * NTHREADS) {
        const int pos = idx >> 3, i = idx & 7;
        const double inv = i == 0 ? 1.0 : i == 1 ? 0.19392274474868576 : i == 2 ? 0.03760603093086393 : i == 3 ? 0.007292664737217109 : i == 4 ? 0.001414213562373095
                         : i == 5 ? 0.0002742481756762073 : i == 6 ? 5.318295896944988e-05 : 1.031338537721246e-05;
        const double t = (double)pos * inv * 0.15915494309189535;
        const float fr = (float)(t - (double)(long long)t);
        __hip_atomic_store(rope + pos * 16 + i, __builtin_amdgcn_cosf(fr), __ATOMIC_RELAXED, __HIP_MEMORY_SCOPE_AGENT);
        __hip_atomic_store(rope + pos * 16 + 8 + i, __builtin_amdgcn_sinf(fr), __ATOMIC_RELAXED, __HIP_MEMORY_SCOPE_AGENT);
    }
    asm volatile("s_waitcnt vmcnt(0)" ::: "memory"); __syncthreads();
    if (tid == 0) __hip_atomic_fetch_add(wcnt, 1u, __ATOMIC_RELAXED, __HIP_MEMORY_SCOPE_AGENT);
    bf16_t* XN = (bf16_t*)(P.ws + WS_XN);
    f32x4 gm[4];
#pragma unroll
    for (int j = 0; j < 4; ++j) gm[j] = ((const f32x4*)P.norm_mix)[lane + 64 * j];
    for (int k = 0; k < 16; k += 2) {
        const int m0 = vcu * 128 + wave + 8 * k, m1 = m0 + 8;
        const f32x4* xr0 = (const f32x4*)(P.x + (size_t)m0 * DM) + lane; const f32x4* xr1 = (const f32x4*)(P.x + (size_t)m1 * DM) + lane;
        f32x4 v0[4], v1[4]; float s0 = 0.f, s1 = 0.f;
#pragma unroll
        for (int j = 0; j < 4; ++j) { v0[j] = xr0[64 * j]; v1[j] = xr1[64 * j]; }
#pragma unroll
        for (int j = 0; j < 4; ++j) { s0 += (v0[j].x * v0[j].x + v0[j].y * v0[j].y) + (v0[j].z * v0[j].z + v0[j].w * v0[j].w); s1 += (v1[j].x * v1[j].x + v1[j].y * v1[j].y) + (v1[j].z * v1[j].z + v1[j].w * v1[j].w); }
        const float rs0 = rsqrtf(wave_sum(s0) * (1.f / DM) + EPS), rs1 = rsqrtf(wave_sum(s1) * (1.f / DM) + EPS);
        u32x2* o0 = (u32x2*)(XN + (size_t)m0 * DM) + lane; u32x2* o1 = (u32x2*)(XN + (size_t)m1 * DM) + lane;
#pragma unroll
        for (int j = 0; j < 4; ++j) { u32x2 w; w.x = cvtpk(v0[j].x * rs0 * gm[j].x, v0[j].y * rs0 * gm[j].y); w.y = cvtpk(v0[j].z * rs0 * gm[j].z, v0[j].w * rs0 * gm[j].w); o0[64 * j] = w;
            u32x2 w1; w1.x = cvtpk(v1[j].x * rs1 * gm[j].x, v1[j].y * rs1 * gm[j].y); w1.y = cvtpk(v1[j].z * rs1 * gm[j].z, v1[j].w * rs1 * gm[j].w); o1[64 * j] = w1; }
    }
}
DI void phase0(const Ptrs& P, LAS unsigned char* lds, int vcu, int G, int wave, int lane, int tid) {
    LAS float* scr = (LAS float*)(lds + wave * 16384);
    const int gw = vcu * NWAVES + wave, NGW = G * NWAVES;
    bf16_t* WIN = (bf16_t*)(P.ws + WS_WIN); bf16_t* WOUT = (bf16_t*)(P.ws + WS_WOUT); bf16_t* WGU = (bf16_t*)(P.ws + WS_WGU); bf16_t* WDN = (bf16_t*)(P.ws + WS_WDN);
    constexpr int I_IN = (DM / 64) * (DIN / 32), I_OUT = (DM / 64) * (DM / 32), I_G = (DM / 64) * (DFF / 32), I_D = (DFF / 64) * (DM / 32);
    constexpr int NITEMS = I_IN + I_OUT + 2 * I_G + I_D;
    (void)WGU; (void)WDN; (void)NITEMS;
    for (int it = gw; it < I_IN + I_OUT; it += NGW) {
        int r = it;
        if (r < I_IN) { p0_transpose_item<0>(P.w_in, DM, DIN, WIN, scr, r, lane, nullptr); continue; } r -= I_IN;
        p0_transpose_item<0>(P.w_out, DM, DM, WOUT, scr, r, lane, nullptr);
    }
    bf16_t* XN = (bf16_t*)(P.ws + WS_XN);
    f32x4 gm[4];
#pragma unroll
    for (int j = 0; j < 4; ++j) gm[j] = ((const f32x4*)P.norm_mix)[lane + 64 * j];
    for (int m = gw; m < MROWS; m += NGW) {
        const f32x4* xr = (const f32x4*)(P.x + (size_t)m * DM) + lane;
        f32x4 v[4]; float s = 0.f;
#pragma unroll
        for (int j = 0; j < 4; ++j) { v[j] = xr[64 * j]; s += (v[j].x * v[j].x + v[j].y * v[j].y) + (v[j].z * v[j].z + v[j].w * v[j].w); }
        const float rs = rsqrtf(wave_sum(s) * (1.f / DM) + EPS);
        u32x2* o8 = (u32x2*)(XN + (size_t)m * DM) + lane;
#pragma unroll
        for (int j = 0; j < 4; ++j) { u32x2 w; w.x = cvtpk(v[j].x * rs * gm[j].x, v[j].y * rs * gm[j].y); w.y = cvtpk(v[j].z * rs * gm[j].z, v[j].w * rs * gm[j].w); o8[64 * j] = w; }
    }
    float* rope = (float*)(P.ws + WS_ROPE);
    for (int idx = vcu * NTHREADS + tid; idx < SEQ * 8; idx += G * NTHREADS) {
        const int pos = idx >> 3, i = idx & 7;
        const double inv = i == 0 ? 1.0 : i == 1 ? 0.19392274474868576 : i == 2 ? 0.03760603093086393 : i == 3 ? 0.007292664737217109 : i == 4 ? 0.001414213562373095
                         : i == 5 ? 0.0002742481756762073 : i == 6 ? 5.318295896944988e-05 : 1.031338537721246e-05;
        const double t = (double)pos * inv * 0.15915494309189535;
        const float fr = (float)(t - (double)(long long)t);
        rope[pos * 16 + i] = __builtin_amdgcn_cosf(fr);
        rope[pos * 16 + 8 + i] = __builtin_amdgcn_sinf(fr);
    }
}

DI void ffn_weights(const Ptrs& P, LAS unsigned char* lds, int part, int nparts, int wave, int lane) {
    LAS float* scr = (LAS float*)(lds + wave * 16384);
    bf16_t* WGU = (bf16_t*)(P.ws + WS_WGU); bf16_t* WDN = (bf16_t*)(P.ws + WS_WDN);
    constexpr int I_G = (DM / 64) * (DFF / 32), I_D = (DFF / 64) * (DM / 32);
    for (int it = part * NWAVES + wave; it < 2 * I_G + I_D; it += nparts * NWAVES) {
        int r = it;
        if (r < I_G) { p0_transpose_item<1>(P.w_gate, DM, DFF, WGU, scr, r, lane, P.norm_ffn); continue; } r -= I_G;
        if (r < I_G) { p0_transpose_item<2>(P.w_up, DM, DFF, WGU, scr, r, lane, P.norm_ffn); continue; } r -= I_G;
        p0_transpose_item<0, true>(P.w_down, DFF, DM, WDN, scr, r, lane, nullptr);
    }
    asm volatile("s_waitcnt vmcnt(0)" ::: "memory"); __syncthreads();
    if (threadIdx.x == 0) __hip_atomic_fetch_add((unsigned*)(P.ws + WS_BAR + 114688), 1u, __ATOMIC_RELAXED, __HIP_MEMORY_SCOPE_AGENT);
}

struct OrdOrder { pg8::StaticOrder S;
    DI bool next(int i, pg8::Unit& u) const { u.ord = i; return S.next(i, u); }
    DI void a_ready(const pg8::Unit&) const {} DI void done(const pg8::Unit&) const {} };
struct QuadOrder { int j, q, nN;
    DI bool next(int i, pg8::Unit& u) const {
        u.ord = i;
        if (nN == 4) { if (i >= 2) return false; u.pm = 2 * j + i; u.pn = q; return true; }
        const int e = 4 * i + q; if (e >= 2 * nN) return false;
        const int hi = e >= nN ? 1 : 0; u.pm = 2 * j + hi; u.pn = e - hi * nN; return true; }
    DI void a_ready(const pg8::Unit&) const {} DI void done(const pg8::Unit&) const {} };
DI void quad_sync(unsigned* flags, int vcu, int nquads, unsigned seq, bool with_nb, int tid) {
    asm volatile("s_waitcnt vmcnt(0)" ::: "memory"); __syncthreads();
    if (tid < 64) {
        const int j = vcu >> 2; const unsigned myx = xb_xcc_id() + 1u;
        const int lo = (with_nb ? max(j - 1, 0) : j) * 4, hi = (with_nb ? min(j + 2, nquads) : j + 1) * 4;
        const int w = lo + tid; const bool act = w < hi;
        const unsigned px = act ? xb_ld(&flags[64 * w + 1]) : myx;
        if (!__all(px == myx)) { __builtin_amdgcn_fence(__ATOMIC_RELEASE, "agent"); asm volatile("s_waitcnt vmcnt(0)" ::: "memory"); }
        if (tid == 0) __hip_atomic_store(&flags[64 * vcu], seq, __ATOMIC_RELAXED, __HIP_MEMORY_SCOPE_AGENT);
        unsigned sp = 0;
        for (;;) { const unsigned v = act ? xb_ld(&flags[64 * w]) : seq; if (__all(v >= seq) || ++sp > (1u << 22)) break; __builtin_amdgcn_s_sleep(1); }
        __builtin_amdgcn_fence(__ATOMIC_ACQUIRE, "agent"); asm volatile("s_waitcnt vmcnt(0)" ::: "memory");
    }
    __syncthreads();
}
constexpr int RS_OFF = 131072 + 1024, RS_MAXU = 14;

struct EpiProj {
    static constexpr bool PERM = true, AFTER_DRAIN = false;
    bf16_t *QA, *KA, *VTA, *QB, *KB, *VTB; const float* rope;
    DI void operator()(const pg8::f32x4 (&acc)[2][2][4][2], const pg8::Unit& u, int wr, int wc, int fr, int fq) const {
        const int lane16 = fr + 16 * fq; (void)lane16;
        const int row0 = u.pm * 256 + wr * 64 + fr;
#pragma unroll
        for (int bj = 0; bj < 2; ++bj) {
            const int colbase = u.pn * 256 + bj * 128;
            const int cl = wc * 32 + fq * 8;
            int kind, c0, pitch; bf16_t* dst;
            if (colbase < 512)       { kind = 0; c0 = colbase;        dst = QA; pitch = 512; }
            else if (colbase < 640)  { kind = 1; c0 = colbase - 512;  dst = KA; pitch = 128; }
            else if (colbase < 768)  { kind = 2; c0 = colbase - 640;  dst = VTA; pitch = 0; }
            else if (colbase < 1280) { kind = 3; c0 = colbase - 768;  dst = QB; pitch = 512; }
            else if (colbase < 1792) { kind = 4; c0 = colbase - 1280; dst = KB; pitch = 512; }
            else                     { kind = 5; c0 = colbase - 1792; dst = VTB; pitch = 0; }
            const bool rope_w = (kind <= 1) && ((wc & 1) == 0);
            const float sc = (kind == 0 || kind == 3) ? QSCALE : 1.f;
#pragma unroll
            for (int ai = 0; ai < 2; ++ai)
#pragma unroll
                for (int m = 0; m < 4; ++m) {
                    const int row = row0 + ai * 128 + m * 16;
                    f32x4 v0 = acc[ai][bj][m][0], v1 = acc[ai][bj][m][1];
                    if (rope_w) {
                        const int pos = row & (SEQ - 1);
                        const f32x4 c0v = *(const f32x4*)(rope + pos * 16), c1v = *(const f32x4*)(rope + pos * 16 + 4);
                        const f32x4 s0v = *(const f32x4*)(rope + pos * 16 + 8), s1v = *(const f32x4*)(rope + pos * 16 + 12);
                        f32x4 p0, p1;
#pragma unroll
                        for (int j = 0; j < 4; ++j) { p0[j] = __shfl_xor(v0[j], 16); p1[j] = __shfl_xor(v1[j], 16); }
                        if (fq == 0) { v0 = v0 * c0v - p0 * s0v; v1 = v1 * c1v - p1 * s1v; }
                        else if (fq == 1) { v0 = v0 * c0v + p0 * s0v; v1 = v1 * c1v + p1 * s1v; }
                    }
                    v0 = v0 * sc; v1 = v1 * sc;
                    if (kind == 2 || kind == 5) {
                        const int b = row >> 13, s = row & (SEQ - 1);
                        const int cc = c0 + cl, head = cc >> 6, dim0 = cc & 63, nh = (kind == 2) ? 2 : 8;
                        bf16_t* vp = dst + (((size_t)(b * nh + head) * (SEQ / 8) + (s >> 3)) * 64 + dim0) * 8 + (s & 7);
#pragma unroll
                        for (int j = 0; j < 4; ++j) { vp[8 * j] = (bf16_t)(cvtpk(v0[j], 0.f) & 0xffffu); vp[8 * (4 + j)] = (bf16_t)(cvtpk(v1[j], 0.f) & 0xffffu); }
                    } else if (kind == 1 || kind == 4) {
                        const int b = row >> 13, s = row & (SEQ - 1);
                        const int cc = c0 + cl, head = cc >> 6, chunk = (cc & 63) >> 3, nh = (kind == 1) ? 2 : 8;
                        u32x4 w; w.x = cvtpk(v0[0], v0[1]); w.y = cvtpk(v0[2], v0[3]); w.z = cvtpk(v1[0], v1[1]); w.w = cvtpk(v1[2], v1[3]);
                        *(u32x4*)(dst + (((size_t)(b * nh + head) * 8 + chunk) * SEQ + s) * 8) = w;
                    } else {
                        u32x4 w; w.x = cvtpk(v0[0], v0[1]); w.y = cvtpk(v0[2], v0[3]); w.z = cvtpk(v1[0], v1[1]); w.w = cvtpk(v1[2], v1[3]);
                        *(u32x4*)(dst + (size_t)row * pitch + c0 + cl) = w;
                    }
                }
        }
    }
};

struct EpiOut {
    static constexpr bool PERM = true, AFTER_DRAIN = false;
    const float* x; bf16_t* h1b; float* ssq;
    DI void operator()(const pg8::f32x4 (&acc)[2][2][4][2], const pg8::Unit& u, int wr, int wc, int fr, int fq) const {
        const int row0 = u.pm * 256 + wr * 64 + fr;
#pragma unroll
        for (int ai = 0; ai < 2; ++ai)
#pragma unroll
            for (int m = 0; m < 4; ++m) {
                const int row = row0 + ai * 128 + m * 16; float ss = 0.f;
#pragma unroll
                for (int bj = 0; bj < 2; ++bj) {
                    const size_t off = (size_t)row * DM + u.pn * 256 + bj * 128 + wc * 32 + 8 * fq;
                    const f32x4 v0 = acc[ai][bj][m][0] + *(const f32x4*)(x + off), v1 = acc[ai][bj][m][1] + *(const f32x4*)(x + off + 4);
                    u32x4 w; w.x = cvtpk(v0[0], v0[1]); w.y = cvtpk(v0[2], v0[3]); w.z = cvtpk(v1[0], v1[1]); w.w = cvtpk(v1[2], v1[3]);
                    *(u32x4*)(h1b + off) = w;
                    ss += (v0[0] * v0[0] + v0[1] * v0[1]) + (v0[2] * v0[2] + v0[3] * v0[3]) + (v1[0] * v1[0] + v1[1] * v1[1]) + (v1[2] * v1[2] + v1[3] * v1[3]);
                }
                ss += __shfl_xor(ss, 16); ss += __shfl_xor(ss, 32);
                if (fq == 0) ssq[(size_t)row * 16 + u.pn * 4 + wc] = ss;
            }
    }
};

struct EpiGU {
    static constexpr bool PERM = true, AFTER_DRAIN = false;
    const LAS float* rsl; const float* cw; const float* cb; bf16_t* act; float* gb; float* ub;
    DI void operator()(const pg8::f32x4 (&acc)[2][2][4][2], const pg8::Unit& u, int wr, int wc, int fr, int fq) const {
        const int lane = fr + 16 * fq;
        const int f0 = u.pn * 128 + wc * 32 + 8 * fq;
        f32x4 w0[2], w1[2], w2[2], bb[2];
#pragma unroll
        for (int n = 0; n < 2; ++n) { w0[n] = *(const f32x4*)(cw + f0 + 4 * n); w1[n] = *(const f32x4*)(cw + DFF + f0 + 4 * n); w2[n] = *(const f32x4*)(cw + 2 * DFF + f0 + 4 * n); bb[n] = *(const f32x4*)(cb + f0 + 4 * n); }
#pragma unroll
        for (int ai = 0; ai < 2; ++ai) {
            const int rowb = u.pm * 256 + ai * 128 + wr * 64;
            const int blk64 = rowb >> 6;
            float rsv[4];
#pragma unroll
            for (int m = 0; m < 4; ++m) {
                rsv[m] = rsl[u.ord * 256 + ai * 128 + wr * 64 + 16 * m + fr];
            }
#pragma unroll
            for (int n = 0; n < 2; ++n) {
                f32x4 g[4], R[4], L[4];
#pragma unroll
                for (int m = 0; m < 4; ++m) { g[m] = acc[ai][0][m][n] * rsv[m];
#pragma unroll
                    for (int j = 0; j < 4; ++j) { R[m][j] = dpp_ror<0x121>(g[m][j]); L[m][j] = dpp_ror<0x12F>(g[m][j]); } }
#pragma unroll
                for (int m = 0; m < 4; ++m) {
                    const int row = rowb + 16 * m + fr;
                    const f32x4 uu = acc[ai][1][m][n] * rsv[m];
                    const f32x4 zero = {0.f, 0.f, 0.f, 0.f};
                    const f32x4 prev = (fr > 0) ? R[m] : (m > 0 ? R[m > 0 ? m - 1 : 0] : zero);
                    const f32x4 next = (fr < 15) ? L[m] : (m < 3 ? L[m < 3 ? m + 1 : 3] : zero);
                    const f32x4 cv = w0[n] * prev + w1[n] * g[m] + w2[n] * next + bb[n];
                    f32x4 a;
#pragma unroll
                    for (int j = 0; j < 4; ++j) a[j] = cv[j] * __builtin_amdgcn_rcpf(1.f + fexp2(-LOG2E * cv[j])) * uu[j];
                    u32x2 wv; wv.x = cvtpk(a[0], a[1]); wv.y = cvtpk(a[2], a[3]);
                    if (m == 0 && fr < 2) *(f32x4*)(gb + ((size_t)(blk64 * 4 + fr)) * DFF + f0 + 4 * n) = g[m];
                    if (m == 3 && fr >= 14) *(f32x4*)(gb + ((size_t)(blk64 * 4 + fr - 12)) * DFF + f0 + 4 * n) = g[m];
                    if (m == 0 && fr == 0) *(f32x4*)(ub + ((size_t)(blk64 * 2 + 0)) * DFF + f0 + 4 * n) = uu;
                    if (m == 3 && fr == 15) *(f32x4*)(ub + ((size_t)(blk64 * 2 + 1)) * DFF + f0 + 4 * n) = uu;
                    const bool edge = (m == 0 && fr == 0) || (m == 3 && fr == 15);
                    if (!edge) *(u32x2*)(act + (size_t)row * DFF + f0 + 4 * n) = wv;
                }
            }
        }
    }
};

struct EpiDownNorm {
    static constexpr bool PERM = true, AFTER_DRAIN = false;
    const bf16_t* h1b; float* out; const float* gfin; float* ssq2; unsigned* cnt;
    DI void operator()(pg8::f32x4 (&acc)[2][2][4][2], const pg8::Unit& u, int wr, int wc, int fr, int fq) const {
        const int row0 = u.pm * 256 + wr * 64 + fr;
#pragma unroll
        for (int ai = 0; ai < 2; ++ai)
#pragma unroll
            for (int m = 0; m < 4; ++m) {
                const int row = row0 + ai * 128 + m * 16; float ss = 0.f;
#pragma unroll
                for (int bj = 0; bj < 2; ++bj) {
                    const size_t off = (size_t)row * DM + u.pn * 256 + bj * 128 + wc * 32 + 8 * fq;
                    const u32x4 hb = *(const u32x4*)(h1b + off);
                    f32x4 r0, r1;
                    r0[0] = __uint_as_float(hb.x << 16); r0[1] = __uint_as_float(hb.x & 0xffff0000u); r0[2] = __uint_as_float(hb.y << 16); r0[3] = __uint_as_float(hb.y & 0xffff0000u);
                    r1[0] = __uint_as_float(hb.z << 16); r1[1] = __uint_as_float(hb.z & 0xffff0000u); r1[2] = __uint_as_float(hb.w << 16); r1[3] = __uint_as_float(hb.w & 0xffff0000u);
                    const f32x4 v0 = acc[ai][bj][m][0] + r0, v1 = acc[ai][bj][m][1] + r1;
                    acc[ai][bj][m][0] = v0; acc[ai][bj][m][1] = v1;
                    ss += (v0[0] * v0[0] + v0[1] * v0[1]) + (v0[2] * v0[2] + v0[3] * v0[3]) + (v1[0] * v1[0] + v1[1] * v1[1]) + (v1[2] * v1[2] + v1[3] * v1[3]);
                }
                ss += __shfl_xor(ss, 16); ss += __shfl_xor(ss, 32);
                if (fq == 0) __hip_atomic_store(ssq2 + ((size_t)u.pn * MROWS + row) * 4 + wc, ss, __ATOMIC_RELAXED, __HIP_MEMORY_SCOPE_AGENT);
            }
        asm volatile("s_waitcnt vmcnt(0)" ::: "memory");
        __builtin_amdgcn_s_barrier(); asm volatile("" ::: "memory");
        if (__builtin_amdgcn_readfirstlane(threadIdx.x >> 6) == 0) {
            unsigned* c = cnt + 64 * u.pm;
            if ((fr | fq) == 0) __hip_atomic_fetch_add(c, 1u, __ATOMIC_RELAXED, __HIP_MEMORY_SCOPE_AGENT);
            unsigned spins = 0;
            while ((unsigned)__builtin_amdgcn_readfirstlane(__hip_atomic_load(c, __ATOMIC_RELAXED, __HIP_MEMORY_SCOPE_AGENT)) < 4u) { __builtin_amdgcn_s_sleep(2); if (++spins > (1u << 22)) break; }
        }
        asm volatile("s_waitcnt vmcnt(0) lgkmcnt(0)" ::: "memory"); __builtin_amdgcn_s_barrier(); asm volatile("" ::: "memory");
#pragma unroll
        for (int ai = 0; ai < 2; ++ai)
#pragma unroll
            for (int m = 0; m < 4; ++m) {
                const int row = row0 + ai * 128 + m * 16;
                const unsigned long long* pp = (const unsigned long long*)(ssq2 + ((size_t)fq * MROWS + row) * 4);
                const unsigned long long pa = __hip_atomic_load(pp, __ATOMIC_RELAXED, __HIP_MEMORY_SCOPE_AGENT), pb = __hip_atomic_load(pp + 1, __ATOMIC_RELAXED, __HIP_MEMORY_SCOPE_AGENT);
                float t = (__uint_as_float((unsigned)pa) + __uint_as_float((unsigned)(pa >> 32))) + (__uint_as_float((unsigned)pb) + __uint_as_float((unsigned)(pb >> 32)));
                t += __shfl_xor(t, 16); t += __shfl_xor(t, 32);
                const float rs = rsqrtf(t * (1.f / DM) + EPS);
#pragma unroll
                for (int bj = 0; bj < 2; ++bj) {
                    const int col0 = u.pn * 256 + bj * 128 + wc * 32 + 8 * fq;
                    const size_t off = (size_t)row * DM + col0;
                    const f32x4 g0 = *(const f32x4*)(gfin + col0), g1 = *(const f32x4*)(gfin + col0 + 4);
                    *(f32x4*)(out + off) = acc[ai][bj][m][0] * rs * g0; *(f32x4*)(out + off + 4) = acc[ai][bj][m][1] * rs * g1;
                }
            }
    }
};

#define MFMA32(a, b, c) __builtin_amdgcn_mfma_f32_32x32x16_bf16((a), (b), (c), 0, 0, 0)
DI int perm_key(int rho) { return (rho & ~12) | ((rho & 4) << 1) | ((rho & 8) >> 1); }
constexpr int RPB_PAD = 64, RPB_FLOATS = RPB_PAD + 8 * 480 + 64;

template <int MODE>
DI void attend(const bf16_t* __restrict__ Qg, const bf16_t* __restrict__ Kg, const bf16_t* __restrict__ VTg, int b, int blk, int h, int lane, float m_init,
               const LAS float* rpbL, LAS float* ssqbuf, const float* __restrict__ gain, bf16_t* __restrict__ mix) {
    const int q = lane & 31, hh = lane >> 5;
    constexpr int KP = MODE == 0 ? 128 : 512, NHV = MODE == 0 ? 2 : 8;
    const int hk = MODE == 0 ? (h >> 2) : h;
    const size_t tokb = (size_t)b * SEQ;
    const int t0 = 64 * blk;
    bf16x8 qf[2][4];
    { const bf16_t* qp = Qg + (tokb + t0 + q) * 512 + h * 64 + 8 * hh;
#pragma unroll
      for (int qt = 0; qt < 2; ++qt)
#pragma unroll
          for (int t = 0; t < 4; ++t) qf[qt][t] = *(const bf16x8*)(qp + (size_t)qt * 32 * 512 + 16 * t); }
    f32x16 o[2][2];
#pragma unroll
    for (int a = 0; a < 2; ++a)
#pragma unroll
        for (int c = 0; c < 2; ++c)
#pragma unroll
            for (int i = 0; i < 16; ++i) o[a][c][i] = 0.f;
    float mrow[2] = {m_init, m_init}, lsum[2];
    lsum[0] = lsum[1] = (MODE == 0 && hh == 0) ? 1.f : 0.f;
    int st_lo, st_hi, rs = 0;
    if (MODE == 0) { st_lo = max(0, 4 - 2 * blk); st_hi = min(10, 260 - 2 * blk); }
    else { rs = min(max(blk - 4, 0), 120); st_lo = 0; st_hi = 16; }
    const bf16_t* kbase = Kg + (((size_t)(b * NHV + hk) * 8 + hh) * SEQ + perm_key(q)) * 8;
    const bf16_t* vbase = VTg + (((size_t)(b * NHV + hk) * (SEQ / 8) + hh) * 64 + q) * 8;
#define WTOK(st) (MODE == 0 ? (t0 - 128 + 32 * (st)) : ((rs + ((st) >> 1)) * 64 + 32 * ((st) & 1)))
#define LOADKV(kd, vd, w) do { _Pragma("unroll") for (int t = 0; t < 4; ++t) kd[t] = *(const bf16x8*)(kbase + ((size_t)(2 * t) * SEQ + (w)) * 8); \
        _Pragma("unroll") for (int dt = 0; dt < 2; ++dt) _Pragma("unroll") for (int s2 = 0; s2 < 2; ++s2) vd[dt][s2] = *(const bf16x8*)(vbase + ((size_t)(((w) >> 3) + 2 * s2) * 64 + 32 * dt) * 8); } while (0)
    bf16x8 kc[4], vc[2][2];
    { const int w = WTOK(st_lo); LOADKV(kc, vc, w); }
    for (int st = st_lo; st < st_hi; ++st) {
        bf16x8 kn[4], vn[2][2];
        { const int stn = min(st + 1, st_hi - 1); const int wn = WTOK(stn); LOADKV(kn, vn, wn); }
        const int w = WTOK(st);
        f32x16 s[2];
#pragma unroll
        for (int qt = 0; qt < 2; ++qt) {
#pragma unroll
            for (int i = 0; i < 16; ++i) s[qt][i] = 0.f;
#pragma unroll
            for (int t = 0; t < 4; ++t) s[qt] = MFMA32(kc[t], qf[qt][t], s[qt]);
        }
        if (MODE == 0) {
            if (st < 2 || st >= 8) {
#pragma unroll
                for (int qt = 0; qt < 2; ++qt) { const int base = w + 8 * hh - (t0 + 32 * qt + q) + 128;
#pragma unroll
                    for (int i = 0; i < 16; ++i) { const int d = base + 16 * (i >> 3) + (i & 7); if ((unsigned)d > 256u) s[qt][i] = -INFINITY; } }
            }
        } else {
            const int c = st & 1, roff = rs + (st >> 1) - blk + 7;
#pragma unroll
            for (int qt = 0; qt < 2; ++qt) { const int qc = 32 * qt + q, cs = min(max(qc - 8, 0), 48), kb = 32 * c + 8 * hh;
                const LAS float* bp = rpbL + RPB_PAD + h * 480 + roff * 32 + kb - qc + 15;
#pragma unroll
                for (int i = 0; i < 16; ++i) { const int off = 16 * (i >> 3) + (i & 7); const int rel = kb + off - cs; const float bias = bp[off];
                    s[qt][i] = (s[qt][i] + bias) + (((unsigned)rel < 16u) ? 0.f : -INFINITY); } }
        }
        bf16x8 pf[2][2];
#pragma unroll
        for (int qt = 0; qt < 2; ++qt) {
            float mx = s[qt][0];
#pragma unroll
            for (int i = 1; i < 16; ++i) mx = fmaxf(mx, s[qt][i]);
            if (__any(mx > mrow[qt] + 8.f)) {
                mx = fmaxf(mx, __shfl_xor(mx, 32));
                const float mnew2 = fmaxf(mrow[qt], mx), alpha = fexp2(mrow[qt] - mnew2);
                mrow[qt] = mnew2; lsum[qt] *= alpha;
#pragma unroll
                for (int i = 0; i < 16; ++i) { o[0][qt][i] *= alpha; o[1][qt][i] *= alpha; }
            }
            const float mnew = mrow[qt];
            float rsum = 0.f;
#pragma unroll
            for (int i = 0; i < 16; ++i) { const float p = fexp2(s[qt][i] - mnew); s[qt][i] = p; rsum += p; }
            lsum[qt] += rsum;
#pragma unroll
            for (int s2 = 0; s2 < 2; ++s2) { u32x4 pk; pk.x = cvtpk(s[qt][8 * s2 + 0], s[qt][8 * s2 + 1]); pk.y = cvtpk(s[qt][8 * s2 + 2], s[qt][8 * s2 + 3]);
                pk.z = cvtpk(s[qt][8 * s2 + 4], s[qt][8 * s2 + 5]); pk.w = cvtpk(s[qt][8 * s2 + 6], s[qt][8 * s2 + 7]); pf[qt][s2] = __builtin_bit_cast(bf16x8, pk); }
        }
#pragma unroll
        for (int dt = 0; dt < 2; ++dt)
#pragma unroll
            for (int qt = 0; qt < 2; ++qt)
#pragma unroll
                for (int s2 = 0; s2 < 2; ++s2) o[dt][qt] = MFMA32(vc[dt][s2], pf[qt][s2], o[dt][qt]);
#pragma unroll
        for (int t = 0; t < 4; ++t) kc[t] = kn[t];
#pragma unroll
        for (int dt = 0; dt < 2; ++dt)
#pragma unroll
            for (int s2 = 0; s2 < 2; ++s2) vc[dt][s2] = vn[dt][s2];
    }
#undef WTOK
#undef LOADKV
#pragma unroll
    for (int qt = 0; qt < 2; ++qt) {
        const float l = lsum[qt] + __shfl_xor(lsum[qt], 32), inv = 1.f / l;
        float ss = 0.f;
#pragma unroll
        for (int dt = 0; dt < 2; ++dt)
#pragma unroll
            for (int i = 0; i < 16; ++i) { const float v = o[dt][qt][i] * inv; o[dt][qt][i] = v; ss += v * v; }
        ss += __shfl_xor(ss, 32);
        if (hh == 0) ssqbuf[h * 64 + 32 * qt + q] = ss;
    }
    __syncthreads();
#pragma unroll
    for (int qt = 0; qt < 2; ++qt) {
        float tot = 0.f;
#pragma unroll
        for (int h2 = 0; h2 < 8; ++h2) tot += ssqbuf[h2 * 64 + 32 * qt + q];
        const float rsn = rsqrtf(tot * (1.f / 512.f) + EPS);
        bf16_t* mp = mix + (tokb + t0 + 32 * qt + q) * DM + h * 64 + 4 * hh;
#pragma unroll
        for (int dt = 0; dt < 2; ++dt)
#pragma unroll
            for (int g = 0; g < 4; ++g) {
                const f32x4 gv = *(const f32x4*)(gain + h * 64 + 32 * dt + 8 * g + 4 * hh);
                u32x2 w; w.x = cvtpk(o[dt][qt][4 * g + 0] * rsn * gv[0], o[dt][qt][4 * g + 1] * rsn * gv[1]);
                w.y = cvtpk(o[dt][qt][4 * g + 2] * rsn * gv[2], o[dt][qt][4 * g + 3] * rsn * gv[3]);
                *(u32x2*)(mp + 32 * dt + 8 * g) = w;
            }
    }
}

#define MFMA16(a, b, c) __builtin_amdgcn_mfma_f32_16x16x32_bf16((a), (b), (c), 0, 0, 0)
template <int MODE>
DI void attend16(const bf16_t* __restrict__ Qg, const bf16_t* __restrict__ Kg, const bf16_t* __restrict__ VTg, int b, int blk, int h, int lane, float sink2,
                 const LAS float* rpbL, LAS float* ssqbuf, const float* __restrict__ gain, bf16_t* __restrict__ mix) {
    constexpr int NG = MODE == 0 ? 9 : 8, BR = MODE == 0 ? 3 : 4, GS = MODE == 0 ? 32 : 64, NHV = MODE == 0 ? 2 : 8;
    const int ql = lane & 15, g = lane >> 4;
    const int hk = MODE == 0 ? (h >> 2) : h;
    const size_t tokb = (size_t)b * SEQ;
    const int t0 = 64 * blk;
    const int rs = min(max(blk - 4, 0), 120);
    bf16_t* mp0 = mix + (tokb + t0 + ql) * DM + h * 64 + 4 * g;
#pragma unroll
    for (int a = 0; a < 4; ++a) {
        const int wa = a == 0 ? 0 : a == 1 ? 8 : a == 2 ? 24 : 32;
        const int qc = 16 * a + ql;
        const int T0 = MODE == 0 ? (t0 + 16 * a - 128) : (rs * 64 + wa);
        bf16x8 qf[2];
        { const bf16_t* qp = Qg + (tokb + t0 + qc) * 512 + h * 64 + 8 * g; qf[0] = *(const bf16x8*)qp; qf[1] = *(const bf16x8*)(qp + 32); }
        const bf16_t* kp = Kg + ((long)((b * NHV + hk) * 8 + g) * SEQ + T0 + 8 * (ql >> 2) + (ql & 3)) * 8;
        const bf16_t* vp = VTg + (((long)(b * NHV + hk) * (SEQ / 8) + T0 / 8 + g) * 64 + ql) * 8;
        float mk[8];
        const LAS float* bp = rpbL + RPB_PAD + h * 480 + (rs - blk + 7) * 32 + (wa + 8 * g - qc + 15);
        if (MODE == 1) { const int cs = min(max(qc - 8, 0), 48), relb = wa + 8 * g - cs;
#pragma unroll
            for (int si = 0; si < 8; ++si) mk[si] = ((unsigned)(relb + si) < 16u) ? 0.f : -INFINITY; }
        f32x4 s[NG][2];
        float mx = MODE == 0 ? sink2 : -INFINITY;
#pragma unroll
        for (int ib = 0; ib < NG; ib += BR) {
            bf16x8 kf[BR][2][2];
#pragma unroll
            for (int i4 = 0; i4 < BR; ++i4)
#pragma unroll
                for (int tau = 0; tau < 2; ++tau)
#pragma unroll
                    for (int t = 0; t < 2; ++t) kf[i4][tau][t] = *(const bf16x8*)(kp + ((long)(4 * t) * SEQ + (ib + i4) * GS + 4 * tau) * 8);
#pragma unroll
            for (int i4 = 0; i4 < BR; ++i4)
#pragma unroll
                for (int tau = 0; tau < 2; ++tau) {
                    const int i = ib + i4;
                    f32x4 z;
                    if (MODE == 1) {
#pragma unroll
                        for (int j = 0; j < 4; ++j) z[j] = bp[32 * i + 4 * tau + j] + mk[4 * tau + j];
                    } else {
#pragma unroll
                        for (int j = 0; j < 4; ++j) { const int key = T0 + 32 * i + 8 * g + 4 * tau + j; const int dd = 32 * i + 8 * g + 4 * tau + j - ql;
                            z[j] = ((unsigned)dd <= 256u && (unsigned)key < (unsigned)SEQ) ? 0.f : -INFINITY; }
                    }
                    z = MFMA16(kf[i4][tau][0], qf[0], z); z = MFMA16(kf[i4][tau][1], qf[1], z); s[i][tau] = z;
                    mx = fmaxf(mx, fmaxf(fmaxf(z[0], z[1]), fmaxf(z[2], z[3])));
                }
        }
        mx = fmaxf(mx, __shfl_xor(mx, 16)); mx = fmaxf(mx, __shfl_xor(mx, 32));
        float lsum = 0.f; bf16x8 pf[NG];
#pragma unroll
        for (int i = 0; i < NG; ++i) {
            float p[8];
#pragma unroll
            for (int tau = 0; tau < 2; ++tau)
#pragma unroll
                for (int j = 0; j < 4; ++j) { p[4 * tau + j] = fexp2(s[i][tau][j] - mx); lsum += p[4 * tau + j]; }
            u32x4 pk; pk.x = cvtpk(p[0], p[1]); pk.y = cvtpk(p[2], p[3]); pk.z = cvtpk(p[4], p[5]); pk.w = cvtpk(p[6], p[7]); pf[i] = __builtin_bit_cast(bf16x8, pk);
        }
        lsum += __shfl_xor(lsum, 16); lsum += __shfl_xor(lsum, 32);
        if (MODE == 0) lsum += fexp2(sink2 - mx);
        f32x4 oo[4];
#pragma unroll
        for (int d = 0; d < 4; ++d) oo[d] = (f32x4){0.f, 0.f, 0.f, 0.f};
#pragma unroll
        for (int ib = 0; ib < NG; ib += BR) {
            bf16x8 vf[BR][4];
#pragma unroll
            for (int i4 = 0; i4 < BR; ++i4)
#pragma unroll
                for (int d = 0; d < 4; ++d) vf[i4][d] = *(const bf16x8*)(vp + ((long)((ib + i4) * (GS / 8)) * 64 + 16 * d) * 8);
#pragma unroll
            for (int i4 = 0; i4 < BR; ++i4)
#pragma unroll
                for (int d = 0; d < 4; ++d) oo[d] = MFMA16(vf[i4][d], pf[ib + i4], oo[d]);
        }
        const float inv = 1.f / lsum;
        float ss = 0.f;
#pragma unroll
        for (int d = 0; d < 4; ++d) {
            const f32x4 v = oo[d] * inv;
            ss += (v[0] * v[0] + v[1] * v[1]) + (v[2] * v[2] + v[3] * v[3]);
            u32x2 w; w.x = cvtpk(v[0], v[1]); w.y = cvtpk(v[2], v[3]);
            *(u32x2*)(mp0 + (size_t)(16 * a) * DM + 16 * d) = w;
        }
        ss += __shfl_xor(ss, 16); ss += __shfl_xor(ss, 32);
        if (g == 0) ssqbuf[h * 64 + 16 * a + ql] = ss;
    }
    __syncthreads();
#pragma unroll
    for (int a = 0; a < 4; ++a) {
        float tot = 0.f;
#pragma unroll
        for (int h2 = 0; h2 < 8; ++h2) tot += ssqbuf[h2 * 64 + 16 * a + ql];
        const float rsn = rsqrtf(tot * (1.f / 512.f) + EPS);
#pragma unroll
        for (int d = 0; d < 4; ++d) {
            const f32x4 gv = *(const f32x4*)(gain + h * 64 + 16 * d + 4 * g);
            u32x2* p = (u32x2*)(mp0 + (size_t)(16 * a) * DM + 16 * d);
            const u32x2 r = *p;
            u32x2 w; w.x = cvtpk(__uint_as_float(r.x << 16) * rsn * gv[0], __uint_as_float(r.x & 0xffff0000u) * rsn * gv[1]);
            w.y = cvtpk(__uint_as_float(r.y << 16) * rsn * gv[2], __uint_as_float(r.y & 0xffff0000u) * rsn * gv[3]);
            *p = w;
        }
    }
}

DI bf16x8 scale_pf(bf16x8 p, float alpha) {
    const u32x4 r = __builtin_bit_cast(u32x4, p); u32x4 w;
    w.x = cvtpk(__uint_as_float(r.x << 16) * alpha, __uint_as_float(r.x & 0xffff0000u) * alpha); w.y = cvtpk(__uint_as_float(r.y << 16) * alpha, __uint_as_float(r.y & 0xffff0000u) * alpha);
    w.z = cvtpk(__uint_as_float(r.z << 16) * alpha, __uint_as_float(r.z & 0xffff0000u) * alpha); w.w = cvtpk(__uint_as_float(r.w << 16) * alpha, __uint_as_float(r.w & 0xffff0000u) * alpha);
    return __builtin_bit_cast(bf16x8, w);
}
template <int DELTA>
DI void attend_b_dual(const bf16_t* __restrict__ Qg, const bf16_t* __restrict__ Kg, const bf16_t* __restrict__ VTg, int b, int blk0, int h, int lane,
                      const LAS float* rpbL, LAS float* ssq0, LAS float* ssq1, bf16_t* __restrict__ mix) {
    constexpr int NR = 8 + DELTA, BR = DELTA ? 3 : 4;
    const int ql = lane & 15, g = lane >> 4;
    const int t0 = 64 * blk0;
    const int rs0 = min(max(blk0 - 4, 0), 120);
    bf16_t* mp0 = mix + ((size_t)b * SEQ + t0 + ql) * DM + h * 64 + 4 * g;
    const char* Kc = (const char*)Kg; const char* Vc = (const char*)VTg; const char* Qc = (const char*)Qg;
    const unsigned kb0 = (unsigned)(((((b * 8 + h) * 8 + g)) * SEQ + rs0 * 64 + 8 * (ql >> 2) + (ql & 3)) * 16);
    const unsigned vb0 = (unsigned)((((b * 8 + h) * (SEQ / 8) + rs0 * 8 + g) * 64 + ql) * 16);
    const unsigned qb0 = (unsigned)(((b * SEQ + t0 + ql) * 512 + h * 64 + 8 * g) * 2);
#pragma unroll
    for (int a = 0; a < 4; ++a) {
        const int wa = a == 0 ? 0 : a == 1 ? 8 : a == 2 ? 24 : 32;
        const int qc = 16 * a + ql;
        bf16x8 qf0[2], qf1[2];
        { unsigned q0_ = qb0; asm volatile("" : "+v"(q0_));
          qf0[0] = *(const bf16x8*)(Qc + (q0_ + (unsigned)(a * 16 * 1024))); qf0[1] = *(const bf16x8*)(Qc + (q0_ + (unsigned)(a * 16 * 1024 + 64)));
          qf1[0] = *(const bf16x8*)(Qc + (q0_ + (unsigned)((64 + a * 16) * 1024))); qf1[1] = *(const bf16x8*)(Qc + (q0_ + (unsigned)((64 + a * 16) * 1024 + 64))); }
        const int cs = min(max(qc - 8, 0), 48), relb = wa + 8 * g - cs;
        float mk[8];
#pragma unroll
        for (int si = 0; si < 8; ++si) mk[si] = ((unsigned)(relb + si) < 16u) ? 0.f : -INFINITY;
        const LAS float* bp0 = rpbL + RPB_PAD + h * 480 + (rs0 - blk0 + 7) * 32 + (wa + 8 * g - qc + 15);
        const LAS float* bp1 = bp0 + (DELTA - 1) * 32;
        float mref0 = -INFINITY, mref1 = -INFINITY, l0 = 0.f, l1 = 0.f; bf16x8 pf0[8], pf1[8];
#pragma unroll
        for (int ib = 0; ib < NR; ib += BR) {
            bf16x8 kf[BR][2][2];
            { unsigned k0_ = kb0; asm volatile("" : "+v"(k0_));
#pragma unroll
              for (int i4 = 0; i4 < BR; ++i4)
#pragma unroll
                  for (int tau = 0; tau < 2; ++tau)
#pragma unroll
                      for (int t = 0; t < 2; ++t) if (ib + i4 < NR) kf[i4][tau][t] = *(const bf16x8*)(Kc + (k0_ + (unsigned)(wa * 16 + (4 * t) * SEQ * 16 + ((ib + i4) * 64 + 4 * tau) * 16))); }
            f32x4 sa[BR][2], sb[BR][2];
            float bm0 = -INFINITY, bm1 = -INFINITY;
#pragma unroll
            for (int i4 = 0; i4 < BR; ++i4)
#pragma unroll
                for (int tau = 0; tau < 2; ++tau) {
                    const int iu = ib + i4, i1 = iu - DELTA;
                    if (iu < 8) { f32x4 z;
#pragma unroll
                        for (int j = 0; j < 4; ++j) z[j] = bp0[32 * iu + 4 * tau + j] + mk[4 * tau + j];
                        z = MFMA16(kf[i4][tau][0], qf0[0], z); z = MFMA16(kf[i4][tau][1], qf0[1], z); sa[i4][tau] = z; bm0 = fmaxf(bm0, fmaxf(fmaxf(z[0], z[1]), fmaxf(z[2], z[3]))); }
                    if (iu < NR && i1 >= 0 && i1 < 8) { f32x4 z;
#pragma unroll
                        for (int j = 0; j < 4; ++j) z[j] = bp1[32 * i1 + 4 * tau + j] + mk[4 * tau + j];
                        z = MFMA16(kf[i4][tau][0], qf1[0], z); z = MFMA16(kf[i4][tau][1], qf1[1], z); sb[i4][tau] = z; bm1 = fmaxf(bm1, fmaxf(fmaxf(z[0], z[1]), fmaxf(z[2], z[3]))); }
                }
            if (__any(bm0 > mref0 + 64.f)) {
                float m = fmaxf(bm0, __shfl_xor(bm0, 16)); m = fmaxf(m, __shfl_xor(m, 32)); m = fmaxf(m, mref0);
                const float alpha = fexp2(mref0 - m); mref0 = m; l0 *= alpha;
#pragma unroll
                for (int i = 0; i < 8; ++i) if (i < ib) pf0[i] = scale_pf(pf0[i], alpha);
            }
            if (__any(bm1 > mref1 + 64.f)) {
                float m = fmaxf(bm1, __shfl_xor(bm1, 16)); m = fmaxf(m, __shfl_xor(m, 32)); m = fmaxf(m, mref1);
                const float alpha = fexp2(mref1 - m); mref1 = m; l1 *= alpha;
#pragma unroll
                for (int i = 0; i < 8; ++i) if (i < ib - DELTA) pf1[i] = scale_pf(pf1[i], alpha);
            }
#pragma unroll
            for (int i4 = 0; i4 < BR; ++i4) {
                const int iu = ib + i4, i1 = iu - DELTA;
                if (iu < 8) { float p[8];
#pragma unroll
                    for (int tau = 0; tau < 2; ++tau)
#pragma unroll
                        for (int j = 0; j < 4; ++j) { p[4 * tau + j] = fexp2(sa[i4][tau][j] - mref0); l0 += p[4 * tau + j]; }
                    u32x4 pk; pk.x = cvtpk(p[0], p[1]); pk.y = cvtpk(p[2], p[3]); pk.z = cvtpk(p[4], p[5]); pk.w = cvtpk(p[6], p[7]); pf0[iu < 8 ? iu : 0] = __builtin_bit_cast(bf16x8, pk); }
                if (iu < NR && i1 >= 0 && i1 < 8) { float p[8];
#pragma unroll
                    for (int tau = 0; tau < 2; ++tau)
#pragma unroll
                        for (int j = 0; j < 4; ++j) { p[4 * tau + j] = fexp2(sb[i4][tau][j] - mref1); l1 += p[4 * tau + j]; }
                    u32x4 pk; pk.x = cvtpk(p[0], p[1]); pk.y = cvtpk(p[2], p[3]); pk.z = cvtpk(p[4], p[5]); pk.w = cvtpk(p[6], p[7]); pf1[(i1 >= 0 && i1 < 8) ? i1 : 0] = __builtin_bit_cast(bf16x8, pk); }
            }
        }
        l0 += __shfl_xor(l0, 16); l0 += __shfl_xor(l0, 32);
        l1 += __shfl_xor(l1, 16); l1 += __shfl_xor(l1, 32);
        f32x4 oo0[4], oo1[4];
#pragma unroll
        for (int d = 0; d < 4; ++d) { oo0[d] = (f32x4){0.f, 0.f, 0.f, 0.f}; oo1[d] = (f32x4){0.f, 0.f, 0.f, 0.f}; }
#pragma unroll
        for (int ib = 0; ib < NR; ib += BR) {
            bf16x8 vf[BR][4];
            { unsigned v0_ = vb0; asm volatile("" : "+v"(v0_));
#pragma unroll
              for (int i4 = 0; i4 < BR; ++i4)
#pragma unroll
                  for (int d = 0; d < 4; ++d) if (ib + i4 < NR) vf[i4][d] = *(const bf16x8*)(Vc + (v0_ + (unsigned)((wa / 8) * 1024 + ((ib + i4) * 8 * 64 + 16 * d) * 16))); }
#pragma unroll
            for (int i4 = 0; i4 < BR; ++i4) {
                const int iu = ib + i4, i1 = iu - DELTA;
#pragma unroll
                for (int d = 0; d < 4; ++d) {
                    if (iu < 8) oo0[d] = MFMA16(vf[i4][d], pf0[iu < 8 ? iu : 0], oo0[d]);
                    if (iu < NR && i1 >= 0 && i1 < 8) oo1[d] = MFMA16(vf[i4][d], pf1[(i1 >= 0 && i1 < 8) ? i1 : 0], oo1[d]);
                }
            }
        }
#pragma unroll
        for (int u = 0; u < 2; ++u) {
            const float inv = 1.f / (u == 0 ? l0 : l1);
            float ss = 0.f;
#pragma unroll
            for (int d = 0; d < 4; ++d) {
                const f32x4 v = (u == 0 ? oo0[d] : oo1[d]) * inv;
                ss += (v[0] * v[0] + v[1] * v[1]) + (v[2] * v[2] + v[3] * v[3]);
                u32x2 w; w.x = cvtpk(v[0], v[1]); w.y = cvtpk(v[2], v[3]);
                *(u32x2*)(mp0 + (size_t)(64 * u + 16 * a) * DM + 16 * d) = w;
            }
            ss += __shfl_xor(ss, 16); ss += __shfl_xor(ss, 32);
            if (g == 0) (u == 0 ? ssq0 : ssq1)[h * 64 + 16 * a + ql] = ss;
        }
    }
}
DI void rescale_b(int b, int blk, int h, int lane, const LAS float* ssqbuf, const float* __restrict__ gain, bf16_t* __restrict__ mix) {
    const int ql = lane & 15, g = lane >> 4;
    const size_t tokb = (size_t)b * SEQ; const int t0 = 64 * blk;
    bf16_t* mp0 = mix + (tokb + t0 + ql) * DM + h * 64 + 4 * g;
#pragma unroll
    for (int a = 0; a < 4; ++a) {
        float tot = 0.f;
#pragma unroll
        for (int h2 = 0; h2 < 8; ++h2) tot += ssqbuf[h2 * 64 + 16 * a + ql];
        const float rsn = rsqrtf(tot * (1.f / 512.f) + EPS);
#pragma unroll
        for (int d = 0; d < 4; ++d) {
            const f32x4 gv = *(const f32x4*)(gain + h * 64 + 16 * d + 4 * g);
            u32x2* p = (u32x2*)(mp0 + (size_t)(16 * a) * DM + 16 * d);
            const u32x2 r = *p;
            u32x2 w; w.x = cvtpk(__uint_as_float(r.x << 16) * rsn * gv[0], __uint_as_float(r.x & 0xffff0000u) * rsn * gv[1]);
            w.y = cvtpk(__uint_as_float(r.y << 16) * rsn * gv[2], __uint_as_float(r.y & 0xffff0000u) * rsn * gv[3]);
            *p = w;
        }
    }
}

DI void phase_attn(const Ptrs& P, LAS unsigned char* lds, int vcu, int G, int wave, int lane, int tid) {
    LAS float* rpbL = (LAS float*)lds;
    LAS float* ssqA = (LAS float*)(lds + 32768);
    LAS float* ssqB = (LAS float*)(lds + 32768 + 4096);
    for (int i = tid; i < RPB_FLOATS; i += NTHREADS) rpbL[i] = 0.f;
    __syncthreads();
    for (int i = tid; i < 8 * 15 * 31; i += NTHREADS) { const int hd = i / 465, rem = i % 465, ro = rem / 31, co = rem % 31; rpbL[RPB_PAD + hd * 480 + ro * 32 + co] = P.rpb[i] * LOG2E; }
    __syncthreads();
    const bf16_t* QA = (const bf16_t*)(P.ws + WS_QA); const bf16_t* KA = (const bf16_t*)(P.ws + WS_KA); const bf16_t* VTA = (const bf16_t*)(P.ws + WS_VTA);
    const bf16_t* QB = (const bf16_t*)(P.ws + WS_QB); const bf16_t* KB = (const bf16_t*)(P.ws + WS_KB); const bf16_t* VTB = (const bf16_t*)(P.ws + WS_VTB);
    bf16_t* MIX = (bf16_t*)(P.ws + WS_MIX);
    constexpr int NUNITS = NBATCH * (SEQ / 64);
    const int per = (NUNITS + G - 1) / G;
    const float sinkv = P.sink[wave] * LOG2E;
    if (per == 2) {
        const int unit0 = vcu * 2;
        if (unit0 < NUNITS) {
            const int b = unit0 >> 7, blk0 = unit0 & 127;
#pragma unroll 1
            for (int u = 0; u < 2; ++u) { int ln = lane; asm volatile("" : "+v"(ln)); attend<0>(QA, KA, VTA, b, blk0 + u, wave, ln, sinkv, rpbL, ssqA, P.norm_a, MIX); }
            LAS float* sB1 = ssqB + 512;
            int ln2 = lane; asm volatile("" : "+v"(ln2));
            const int rs0 = min(max(blk0 - 4, 0), 120), rs1 = min(max(blk0 - 3, 0), 120);
            if (rs1 != rs0) attend_b_dual<1>(QB, KB, VTB, b, blk0, wave, ln2, rpbL, ssqB, sB1, MIX + 512);
            else attend_b_dual<0>(QB, KB, VTB, b, blk0, wave, ln2, rpbL, ssqB, sB1, MIX + 512);
            __syncthreads();
            rescale_b(b, blk0, wave, lane, ssqB, P.norm_b, MIX + 512);
            rescale_b(b, blk0 + 1, wave, lane, sB1, P.norm_b, MIX + 512);
        }
    } else
    for (int uu = 0; uu < per; ++uu) {
        const int unit = vcu * per + uu; if (unit >= NUNITS) break;
        const int b = unit >> 7, blk = unit & 127;
        int ln = lane; asm volatile("" : "+v"(ln));
        attend<0>(QA, KA, VTA, b, blk, wave, ln, sinkv, rpbL, ssqA, P.norm_a, MIX);
        int ln2 = lane; asm volatile("" : "+v"(ln2));
        attend16<1>(QB, KB, VTB, b, blk, wave, ln2, 0.f, rpbL, ssqB, P.norm_b, MIX + 512);
    }
    __syncthreads();
}

DI void fixup_rows(const Ptrs& P, int rowi0, int nrows, int t, int nthr) {
    const float* gb = (const float*)(P.ws + WS_GB); const float* ub = (const float*)(P.ws + WS_UB); bf16_t* act = (bf16_t*)(P.ws + WS_ACT);
    constexpr int F4 = DFF / 4;
    for (int it = t; it < nrows * F4; it += nthr) {
        const int rowi = rowi0 + it / F4, f = 4 * (it % F4), blk64 = rowi >> 1, side = rowi & 1;
        const f32x4 zero = {0.f, 0.f, 0.f, 0.f};
        f32x4 gp, gc, gn, uv; int row;
        if (side == 0) {
            row = blk64 * 64;
            gp = (blk64 & 127) == 0 ? zero : *(const f32x4*)(gb + ((size_t)((blk64 - 1) * 4 + 3)) * DFF + f);
            gc = *(const f32x4*)(gb + ((size_t)(blk64 * 4 + 0)) * DFF + f);
            gn = *(const f32x4*)(gb + ((size_t)(blk64 * 4 + 1)) * DFF + f);
            uv = *(const f32x4*)(ub + ((size_t)(blk64 * 2 + 0)) * DFF + f);
        } else {
            row = blk64 * 64 + 63;
            gp = *(const f32x4*)(gb + ((size_t)(blk64 * 4 + 2)) * DFF + f);
            gc = *(const f32x4*)(gb + ((size_t)(blk64 * 4 + 3)) * DFF + f);
            gn = (blk64 & 127) == 127 ? zero : *(const f32x4*)(gb + ((size_t)((blk64 + 1) * 4 + 0)) * DFF + f);
            uv = *(const f32x4*)(ub + ((size_t)(blk64 * 2 + 1)) * DFF + f);
        }
        const f32x4 w0 = *(const f32x4*)(P.conv_w + f), w1 = *(const f32x4*)(P.conv_w + DFF + f), w2 = *(const f32x4*)(P.conv_w + 2 * DFF + f), bb = *(const f32x4*)(P.conv_b + f);
        const f32x4 cv = w0 * gp + w1 * gc + w2 * gn + bb;
        f32x4 a;
#pragma unroll
        for (int j = 0; j < 4; ++j) a[j] = cv[j] * __builtin_amdgcn_rcpf(1.f + fexp2(-LOG2E * cv[j])) * uv[j];
        u32x2 w; w.x = cvtpk(a[0], a[1]); w.y = cvtpk(a[2], a[3]);
        *(u32x2*)(act + (size_t)row * DFF + f) = w;
    }
}

DI void phase_final(const Ptrs& P, int vcu, int G, int wave, int lane) {
    const int gw = vcu * NWAVES + wave, NGW = G * NWAVES;
    f32x4 gm[4];
#pragma unroll
    for (int j = 0; j < 4; ++j) gm[j] = ((const f32x4*)P.norm_final)[lane + 64 * j];
    for (int m = gw; m < MROWS; m += NGW) {
        f32x4* xr = (f32x4*)(P.out + (size_t)m * DM) + lane;
        f32x4 v[4]; float s = 0.f;
#pragma unroll
        for (int j = 0; j < 4; ++j) { v[j] = xr[64 * j]; s += (v[j].x * v[j].x + v[j].y * v[j].y) + (v[j].z * v[j].z + v[j].w * v[j].w); }
        const float rs = rsqrtf(wave_sum(s) * (1.f / DM) + EPS);
#pragma unroll
        for (int j = 0; j < 4; ++j) xr[64 * j] = v[j] * rs * gm[j];
    }
}

struct Args { const float* in[15]; float* out; unsigned char* ws; int ph_lo, ph_hi; };
static_assert(sizeof(Args) == 15 * 8 + 8 + 8 + 8, "Args has no padding");

__global__ void __launch_bounds__(NTHREADS, 2) hybrid_fwd(Args a) {
    extern __shared__ __attribute__((aligned(16))) unsigned char lds_raw[];
    LAS unsigned char* lds = (LAS unsigned char*)lds_raw;
    const int tid = threadIdx.x, lane = tid & 63, wave = __builtin_amdgcn_readfirstlane(tid >> 6);
    const int G = gridDim.x, bx = blockIdx.x;
    const int vcu = (G % 8 == 0) ? (bx % 8) * (G / 8) + bx / 8 : bx;
    Ptrs P;
    P.x = a.in[0]; P.norm_mix = a.in[1]; P.w_in = a.in[2]; P.sink = a.in[3]; P.rpb = a.in[4]; P.norm_a = a.in[5]; P.norm_b = a.in[6]; P.w_out = a.in[7];
    P.norm_ffn = a.in[8]; P.w_gate = a.in[9]; P.w_up = a.in[10]; P.conv_w = a.in[11]; P.conv_b = a.in[12]; P.w_down = a.in[13]; P.norm_final = a.in[14];
    P.out = a.out; P.ws = a.ws;
    const int lo = a.ph_lo, hi = a.ph_hi;
#define IN(k) (lo <= (k) && (k) < hi)
#ifndef PROBE_REPEAT
#define PROBE_REPEAT -1
#endif
    unsigned char* ws = a.ws;
#if MK_N_LAUNCHES == 1
    volatile LAS unsigned* st = (volatile LAS unsigned*)(lds + 131072);
    unsigned* barw = (unsigned*)(ws + WS_BAR);
    if (tid < 2) st[tid] = 0u;
    __syncthreads();
    XcdBarrier xb = xcd_barrier_post(barw, st);
    unsigned* qflags = (unsigned*)(ws + WS_BAR + 16384 + 32768);
    if (tid == 0) __hip_atomic_store(&qflags[64 * vcu + 1], xb_xcc_id() + 1u, __ATOMIC_RELAXED, __HIP_MEMORY_SCOPE_AGENT);
    const bool quads = (G == 256);
#define QSYNC(k, seq, nb) do { if (IN(k) && IN((k) + 1)) { if (quads) quad_sync(qflags, vcu, G / 4, (seq), (nb), tid); else xcd_barrier(xb); } } while (0)
#define SEAM(k) do { if (IN(k) && IN((k) + 1)) { xcd_barrier(xb); } } while (0)
#else
#define SEAM(k) do { } while (0)
#define QSYNC(k, seq, nb) do { } while (0)
    const bool quads = (G == 256);
#endif
    if (IN(0)) {
#if MK_N_LAUNCHES == 1
        if (quads) {
            unsigned* wcnt = (unsigned*)(ws + WS_BAR + 114688 + 128);
            phase0_local(P, lds, vcu, G, wave, lane, tid, wcnt);
            if (IN(1)) {
                if (tid == 0) { unsigned sp = 0; while (xb_ld(wcnt) < (unsigned)G) { __builtin_amdgcn_s_sleep(2); if (++sp > (1u << 22)) break; } }
                quad_sync(qflags, vcu, G / 4, 1u, false, tid);
            }
        } else
#endif
        { phase0(P, lds, vcu, G, wave, lane, tid); __syncthreads(); SEAM(0); }
    }
    if (IN(1)) {
        pg8::Gemm g{(const bf16_t*)(ws + WS_XN), (const bf16_t*)(ws + WS_WIN), MROWS, DIN, DM}; pg8::StaticOrder S; S.init(MROWS, DIN, G, bx);
        EpiProj E{(bf16_t*)(ws + WS_QA), (bf16_t*)(ws + WS_KA), (bf16_t*)(ws + WS_VTA), (bf16_t*)(ws + WS_QB), (bf16_t*)(ws + WS_KB), (bf16_t*)(ws + WS_VTB), (const float*)(ws + WS_ROPE)};
        if (quads) {
            QuadOrder Q{vcu >> 2, vcu & 3, DIN / 256};
            pg8::gemm_phase<EpiProj, QuadOrder, true, true>(lds, g, Q, E);
            if ((vcu & 3) >= 2) ffn_weights(P, lds, (vcu >> 2) * 2 + (vcu & 1), G / 2, wave, lane);
        } else {
            pg8::gemm_phase<EpiProj, pg8::StaticOrder, true, true>(lds, g, S, E);
            { constexpr int NU = (MROWS / 256) * (DIN / 256); const int rem = NU % G;
              if (rem == 0) ffn_weights(P, lds, bx, G, wave, lane); else if (bx >= rem) ffn_weights(P, lds, bx - rem, G - rem, wave, lane); }
        }
        QSYNC(1, 2u, true);
    }
    if (IN(2)) { phase_attn(P, lds, vcu, G, wave, lane, tid); QSYNC(2, 3u, false); }
    if (IN(3)) {
        pg8::Gemm g{(const bf16_t*)(ws + WS_MIX), (const bf16_t*)(ws + WS_WOUT), MROWS, DM, DM}; pg8::StaticOrder S; S.init(MROWS, DM, G, bx);
        EpiOut E{P.x, (bf16_t*)(ws + WS_H1B), (float*)(ws + WS_SSQ1)};
        if (quads) { QuadOrder Q{vcu >> 2, vcu & 3, 4}; pg8::gemm_phase<EpiOut, QuadOrder, true, true>(lds, g, Q, E); }
        else pg8::gemm_phase<EpiOut, pg8::StaticOrder, true, true>(lds, g, S, E);
#if MK_N_LAUNCHES == 1
        if (quads && IN(4)) { if (tid == 0) { unsigned sp = 0; while (xb_ld((unsigned*)(ws + WS_BAR + 114688)) < (unsigned)(G / 2)) { __builtin_amdgcn_s_sleep(2); if (++sp > (1u << 22)) break; } } }
#endif
        QSYNC(3, 4u, false);
    }
    if (IN(4)) {
        pg8::Gemm g{(const bf16_t*)(ws + WS_H1B), (const bf16_t*)(ws + WS_WGU), MROWS, NGU, DM}; pg8::StaticOrder S; S.init(MROWS, NGU, G, bx);
        LAS float* rsl = (LAS float*)(lds + RS_OFF);
        QuadOrder Q{vcu >> 2, vcu & 3, NGU / 256};
        { const float* ssq1 = (const float*)(ws + WS_SSQ1); pg8::Unit u0;
          for (int i = 0; i < RS_MAXU && (quads ? Q.next(i, u0) : S.next(i, u0)); ++i) if (tid < 256) {
              const f32x4* pz = (const f32x4*)(ssq1 + (size_t)(u0.pm * 256 + tid) * 16);
              const f32x4 p0 = pz[0], p1 = pz[1], p2 = pz[2], p3 = pz[3];
              const float t = (((p0.x + p0.y) + (p0.z + p0.w)) + ((p1.x + p1.y) + (p1.z + p1.w))) + (((p2.x + p2.y) + (p2.z + p2.w)) + ((p3.x + p3.y) + (p3.z + p3.w)));
              rsl[i * 256 + tid] = rsqrtf(t * (1.f / DM) + EPS); }
          __syncthreads(); }
        EpiGU E{rsl, P.conv_w, P.conv_b, (bf16_t*)(ws + WS_ACT), (float*)(ws + WS_GB), (float*)(ws + WS_UB)};
        if (quads) pg8::gemm_phase<EpiGU, QuadOrder, true, true>(lds, g, Q, E);
        else { OrdOrder SO{S}; pg8::gemm_phase<EpiGU, OrdOrder, true, true>(lds, g, SO, E); }
        QSYNC(4, 5u, true);
    }
    if (IN(5)) {
        QuadOrder Q{vcu >> 2, vcu & 3, 4};
        if (quads && MK_N_LAUNCHES == 1) {
            fixup_rows(P, 16 * (vcu >> 2) + 4 * (vcu & 3), 4, tid, NTHREADS);
#if MK_N_LAUNCHES == 1
            quad_sync(qflags, vcu, G / 4, 6u, false, tid);
#endif
        } else {
          pg8::StaticOrder S0; S0.init(MROWS, DM, G, bx); pg8::Unit u0; int last = -1;
          for (int i = 0; S0.next(i, u0); ++i) { if (u0.pm != last) fixup_rows(P, 8 * u0.pm, 8, tid, NTHREADS); last = u0.pm; }
          asm volatile("s_waitcnt vmcnt(0)" ::: "memory"); __syncthreads(); }
        pg8::Gemm g{(const bf16_t*)(ws + WS_ACT), (const bf16_t*)(ws + WS_WDN), MROWS, DM, DFF}; pg8::StaticOrder S; S.init(MROWS, DM, G, bx);
        EpiDownNorm E{(const bf16_t*)(ws + WS_H1B), P.out, P.norm_final, (float*)(ws + WS_SSQ2), (unsigned*)(ws + WS_BAR + 16384)};
        if (quads) pg8::gemm_phase<EpiDownNorm, QuadOrder, true, true>(lds, g, Q, E);
        else pg8::gemm_phase<EpiDownNorm, pg8::StaticOrder, true, true>(lds, g, S, E);
    }
#undef IN
#undef SEAM
#undef QSYNC
}

extern "C" void kernel_launch(void* const* d_in, const int* in_sizes, int n_in, void* d_out, int out_size, void* d_ws, size_t ws_size, hipStream_t stream) {
    static int grid = 0;
    if (grid == 0) {
        if (n_in != 15 || in_sizes[0] != MROWS * DM || out_size != MROWS * DM || ws_size < WS_END) {
            fprintf(stderr, "kernel_launch: unexpected shapes (n_in %d, in0 %d, out %d, ws %zu); nothing launched\n", n_in, n_in > 0 ? in_sizes[0] : -1, out_size, ws_size); grid = -1; return; }
        int dev = 0, cus = 0, per_cu = 0;
        if (hipGetDevice(&dev) != hipSuccess || hipDeviceGetAttribute(&cus, hipDeviceAttributeMultiprocessorCount, dev) != hipSuccess) { fprintf(stderr, "kernel_launch: device query failed\n"); grid = -1; return; }
        if (hipFuncSetAttribute((const void*)hybrid_fwd, hipFuncAttributeMaxDynamicSharedMemorySize, LDS_BYTES) != hipSuccess) { fprintf(stderr, "kernel_launch: hipFuncSetAttribute failed\n"); grid = -1; return; }
        if (hipOccupancyMaxActiveBlocksPerMultiprocessor(&per_cu, (const void*)hybrid_fwd, NTHREADS, LDS_BYTES) != hipSuccess || per_cu < 1) {
            fprintf(stderr, "kernel_launch: occupancy query reports %d workgroups per CU; nothing launched\n", per_cu); (void)hipGetLastError(); grid = -1; return; }
        grid = cus;
    }
    if (grid < 0) return;
    Args a{};
    for (int i = 0; i < 15; ++i) a.in[i] = (const float*)d_in[i];
    a.out = (float*)d_out; a.ws = (unsigned char*)d_ws;
    if (hipMemsetAsync((char*)d_ws + WS_BAR, 0, 114688 + 256, stream) != hipSuccess) { fprintf(stderr, "kernel_launch: memset of the barrier words failed\n"); return; }
#if MK_N_LAUNCHES == 1
    a.ph_lo = 0; a.ph_hi = NPHASE;
    hipLaunchKernelGGL(hybrid_fwd, dim3(grid), dim3(NTHREADS), LDS_BYTES, stream, a);
#else
    for (int p = 0; p < NPHASE; ++p) {
        a.ph_lo = p; a.ph_hi = p + 1;
        hipLaunchKernelGGL(hybrid_fwd, dim3(grid), dim3(NTHREADS), LDS_BYTES, stream, a);
        if (p == PROBE_REPEAT) hipLaunchKernelGGL(hybrid_fwd, dim3(grid), dim3(NTHREADS), LDS_BYTES, stream, a);
    }
#endif
}
```

```cpp
#include <hip/hip_runtime.h>
#include <hip/hip_cooperative_groups.h>
#include <cstdio>
#include <cstdint>
#include <cmath>
namespace cg = cooperative_groups;
namespace pg8 {
#define PG8_LAS __attribute__((address_space(3)))
typedef unsigned short bf16_t;
typedef short bf16x8 __attribute__((ext_vector_type(8)));
typedef float f32x4 __attribute__((ext_vector_type(4)));
typedef unsigned u32x4 __attribute__((ext_vector_type(4)));
constexpr int BM = 256, BK = 64, HALF = 128, HTB = HALF * BK * 2  , STAGE_BYTES = 8 * HTB, NXCD = 8, WGM = 8;

__host__ __device__ __forceinline__ int lds_byte(int r, int c) { const int st = (r >> 4) * 2 + (c >> 5), rr = r & 15, cc = c & 31, ob = rr * 64 + cc * 2; return st * 1024 + (ob ^ (((ob >> 9) & 1) << 5)); }
__host__ __device__ __forceinline__ void stage_rc(int b, int& R, int& C) { const int st = b / 1024, sb = b % 1024, swz = sb ^ (((sb >> 9) & 1) << 5); R = (st >> 1) * 16 + swz / 64; C = (st & 1) * 32 + (swz % 64) / 2; }
__host__ __device__ __forceinline__ int perm32(int rho) { const int n = rho >> 4, i = rho & 15; return 8 * (i >> 2) + 4 * n + (i & 3); }

struct Unit { int pm, pn, ord; };
struct Gemm { const bf16_t* A; const bf16_t* Bt; int M, N, K; };

struct StaticOrder {
    int nM, nN, nwg, G, c;
    __host__ __device__ __forceinline__ void init(int M, int N, int G_, int c_) { nM = M / BM; nN = N / BM; nwg = nM * nN; G = G_; c = c_; }
    __host__ __device__ __forceinline__ bool next(int i, Unit& u) const {
        const long L = (long)i * G + c; if (L >= nwg) return false;
        int wgid = (int)L; { const int q = nwg / NXCD, r = nwg % NXCD, xcd = wgid % NXCD, off = wgid / NXCD; wgid = (xcd < r ? xcd * (q + 1) : r * (q + 1) + (xcd - r) * q) + off; }
        const int nig = WGM * nN, gid = wgid / nig, fm = gid * WGM, gsz = (nM - fm) < WGM ? (nM - fm) : WGM;
        u.pm = fm + ((wgid % nig) % gsz); u.pn = (wgid % nig) / gsz; return true;
    }
    __device__ __forceinline__ void a_ready(const Unit&) const {}
    __device__ __forceinline__ void done(const Unit&) const {}
};
__device__ __forceinline__ unsigned cvt_pk_bf16(float lo, float hi) { unsigned r; asm volatile("v_cvt_pk_bf16_f32 %0, %1, %2" : "=v"(r) : "v"(lo), "v"(hi)); return r; }
typedef float f32x2 __attribute__((ext_vector_type(2)));
template <class Epi, class Sched, bool ALIGN_EPI = false, bool SP2 = false>
__device__ __forceinline__ void gemm_phase(PG8_LAS unsigned char* lds, const Gemm g, const Sched& S, const Epi& E) {
    const int tid = threadIdx.x, wid = __builtin_amdgcn_readfirstlane(tid >> 6), lane = tid & 63, wr = wid >> 2, wc = wid & 3, fr = lane & 15, fq = lane >> 4;
    const int K = g.K, nt = K / BK;
    unsigned voffA[2], voffB[2];
#pragma unroll
    for (int i = 0; i < 2; ++i) { int R, C; stage_rc(tid * 16 + i * 8192, R, C); const int Rb = Epi::PERM ? ((R & ~31) + perm32(R & 31)) : R;
        voffA[i] = (unsigned)(R * K + C) * 2u; voffB[i] = (unsigned)(Rb * K + C) * 2u; }
    const size_t kstep = (size_t)(BK * 2);
    const size_t hstep = (size_t)HALF * K * 2;
    const size_t tstep = 2 * hstep;
    const unsigned ldsw = (unsigned)wid * 1024u;
    const int aoff = lds_byte(wr * 64 + fr, fq * 8), boff = lds_byte(wc * 32 + fr, fq * 8);
#define PG8_SA(b, h) (((b) * 2 + (h)) * HTB)
#define PG8_SB(b, h) ((4 + (b) * 2 + (h)) * HTB)
#define PG8_STAGE(bufoff, gbase, voff) do { _Pragma("unroll") for (int _i = 0; _i < 2; ++_i) \
        __builtin_amdgcn_global_load_lds((const unsigned*)((const char*)(gbase) + (voff)[_i]), (PG8_LAS unsigned*)(lds + (bufoff) + ldsw + _i * 8192), 16, 0, 0); } while (0)
#define PG8_LDA(dst, b, h) do { _Pragma("unroll") for (int m = 0; m < 4; ++m) _Pragma("unroll") for (int k = 0; k < 2; ++k) dst[m][k] = *(const PG8_LAS bf16x8*)(lds + PG8_SA(b, h) + aoff + m * 2048 + k * 1024); } while (0)
#define PG8_LDB(dst, b, h) do { _Pragma("unroll") for (int n = 0; n < 2; ++n) _Pragma("unroll") for (int k = 0; k < 2; ++k) dst[n][k] = *(const PG8_LAS bf16x8*)(lds + PG8_SB(b, h) + boff + n * 2048 + k * 1024); } while (0)
#define PG8_MMA(ai, bj, At, Bt) do { __builtin_amdgcn_s_setprio(1); _Pragma("unroll") for (int m = 0; m < 4; ++m) _Pragma("unroll") for (int n = 0; n < 2; ++n) _Pragma("unroll") for (int k = 0; k < 2; ++k) \
        acc[ai][bj][m][n] = __builtin_amdgcn_mfma_f32_16x16x32_bf16(Bt[n][k], At[m][k], acc[ai][bj][m][n], 0, 0, 0); __builtin_amdgcn_s_setprio(0); } while (0)
#define PG8_WAIT_V(n) asm volatile("s_waitcnt vmcnt(" #n ")" ::: "memory")
#define PG8_WAIT_L(n) asm volatile("s_waitcnt lgkmcnt(" #n ")" ::: "memory")
#define PG8_BAR __builtin_amdgcn_s_barrier()
#define PG8_SCHED __builtin_amdgcn_sched_barrier(0)
    Unit cur, nxt; int ui = 0;
    if (!S.next(0, cur)) return;
    f32x4 acc[2][2][4][2];
#pragma unroll
    for (int a = 0; a < 2; ++a)
#pragma unroll
        for (int b = 0; b < 2; ++b)
#pragma unroll
            for (int m = 0; m < 4; ++m)
#pragma unroll
                for (int n = 0; n < 2; ++n) acc[a][b][m][n] = (f32x4){0.f, 0.f, 0.f, 0.f};
    bf16x8 At[4][2], B0[2][2], B1[2][2];
    const char* cA = (const char*)g.A + (size_t)cur.pm * tstep; const char* cB = (const char*)g.Bt + (size_t)cur.pn * tstep;
    S.a_ready(cur);
    if constexpr (SP2) {
        PG8_STAGE(PG8_SB(0, 0), cB, voffB); PG8_STAGE(PG8_SB(0, 1), cB + hstep, voffB); PG8_STAGE(PG8_SA(0, 0), cA, voffA); PG8_STAGE(PG8_SA(0, 1), cA + hstep, voffA);
        if (wr == 1) PG8_BAR;
        PG8_WAIT_V(2); PG8_BAR;
        PG8_STAGE(PG8_SB(1, 0), cB + kstep, voffB); PG8_STAGE(PG8_SA(1, 0), cA + kstep, voffA); PG8_STAGE(PG8_SB(1, 1), cB + hstep + kstep, voffB);
        PG8_WAIT_V(6); PG8_BAR;
    } else {
        PG8_STAGE(PG8_SB(0, 0), cB, voffB); PG8_STAGE(PG8_SA(0, 0), cA, voffA); PG8_STAGE(PG8_SB(0, 1), cB + hstep, voffB); PG8_STAGE(PG8_SA(0, 1), cA + hstep, voffA);
        if (wr == 1) PG8_BAR;
        PG8_WAIT_V(4); PG8_BAR;
        PG8_STAGE(PG8_SB(1, 0), cB + kstep, voffB); PG8_STAGE(PG8_SA(1, 0), cA + kstep, voffA); PG8_STAGE(PG8_SB(1, 1), cB + hstep + kstep, voffB);
        PG8_WAIT_V(6); PG8_BAR;
    }
    for (;;) {
        const bool has_next = S.next(ui + 1, nxt);
        const char* nA = has_next ? (const char*)g.A + (size_t)nxt.pm * tstep : cA; const char* nB = has_next ? (const char*)g.Bt + (size_t)nxt.pn * tstep : cB;
        for (int t = 0; t < nt; t += 2) {
            const bool last = (t == nt - 2);
            const char* a1 = cA + (size_t)(t + 1) * kstep;
            const char* a2 = last ? nA : cA + (size_t)(t + 2) * kstep; const char* b2 = last ? nB : cB + (size_t)(t + 2) * kstep;
            const char* a3 = a2 + kstep; const char* b3 = b2 + kstep;
            if (last && has_next) S.a_ready(nxt);
            if constexpr (SP2) {
            PG8_LDB(B0, 0, 0); PG8_LDB(B1, 0, 1); PG8_SCHED; PG8_LDA(At, 0, 0); PG8_STAGE(PG8_SA(1, 1), a1 + hstep, voffA);
            PG8_WAIT_V(8); PG8_WAIT_L(0); PG8_BAR; PG8_MMA(0, 0, At, B0); PG8_MMA(0, 1, At, B1); PG8_BAR; PG8_SCHED;
            PG8_LDA(At, 0, 1); PG8_STAGE(PG8_SB(0, 0), b2, voffB); PG8_STAGE(PG8_SB(0, 1), b2 + hstep, voffB); PG8_STAGE(PG8_SA(0, 0), a2, voffA);
            PG8_WAIT_V(8); PG8_WAIT_L(0); PG8_BAR; PG8_MMA(1, 0, At, B0); PG8_MMA(1, 1, At, B1); PG8_BAR; PG8_SCHED;
            PG8_LDB(B0, 1, 0); PG8_LDB(B1, 1, 1); PG8_SCHED; PG8_LDA(At, 1, 0); PG8_STAGE(PG8_SA(0, 1), a2 + hstep, voffA);
            PG8_WAIT_V(8); PG8_WAIT_L(0); PG8_BAR; PG8_MMA(0, 0, At, B0); PG8_MMA(0, 1, At, B1); PG8_BAR; PG8_SCHED;
            PG8_LDA(At, 1, 1); PG8_STAGE(PG8_SB(1, 0), b3, voffB); PG8_STAGE(PG8_SB(1, 1), b3 + hstep, voffB); PG8_STAGE(PG8_SA(1, 0), a3, voffA);
            PG8_WAIT_V(8); PG8_WAIT_L(0); PG8_BAR; PG8_MMA(1, 0, At, B0); PG8_MMA(1, 1, At, B1); PG8_BAR; PG8_SCHED;
            } else {
            PG8_LDB(B0, 0, 0); PG8_SCHED; PG8_LDA(At, 0, 0); PG8_STAGE(PG8_SA(1, 1), a1 + hstep, voffA);
            PG8_WAIT_L(8); PG8_BAR; PG8_WAIT_L(0); PG8_MMA(0, 0, At, B0); PG8_BAR; PG8_SCHED;
            PG8_LDB(B1, 0, 1); PG8_STAGE(PG8_SB(0, 0), b2, voffB);
            PG8_BAR; PG8_WAIT_L(0); PG8_MMA(0, 1, At, B1); PG8_BAR;
            PG8_LDA(At, 0, 1); PG8_STAGE(PG8_SA(0, 0), a2, voffA);
            PG8_BAR; PG8_WAIT_L(0); PG8_MMA(1, 0, At, B0); PG8_BAR; PG8_SCHED;
            PG8_STAGE(PG8_SB(0, 1), b2 + hstep, voffB);
            PG8_WAIT_V(6); PG8_BAR; PG8_MMA(1, 1, At, B1); PG8_BAR;
            PG8_LDB(B0, 1, 0); PG8_SCHED; PG8_LDA(At, 1, 0); PG8_STAGE(PG8_SA(0, 1), a2 + hstep, voffA);
            PG8_WAIT_L(8); PG8_BAR; PG8_WAIT_L(0); PG8_MMA(0, 0, At, B0); PG8_BAR; PG8_SCHED;
            PG8_LDB(B1, 1, 1); PG8_STAGE(PG8_SB(1, 0), b3, voffB);
            PG8_BAR; PG8_WAIT_L(0); PG8_MMA(0, 1, At, B1); PG8_BAR;
            PG8_LDA(At, 1, 1); PG8_STAGE(PG8_SA(1, 0), a3, voffA);
            PG8_BAR; PG8_WAIT_L(0); PG8_MMA(1, 0, At, B0); PG8_BAR; PG8_SCHED;
            PG8_STAGE(PG8_SB(1, 1), b3 + hstep, voffB);
            PG8_WAIT_V(6); PG8_BAR; PG8_MMA(1, 1, At, B1); PG8_BAR;
            }
        }
        if constexpr (ALIGN_EPI) { if (wr == 0) PG8_BAR; }
        if constexpr (!Epi::AFTER_DRAIN) { E(acc, cur, wr, wc, fr, fq); S.done(cur); }
        if (!has_next) break;
#pragma unroll
        for (int a = 0; a < 2; ++a)
#pragma unroll
            for (int b = 0; b < 2; ++b)
#pragma unroll
                for (int m = 0; m < 4; ++m)
#pragma unroll
                    for (int n = 0; n < 2; ++n) acc[a][b][m][n] = (f32x4){0.f, 0.f, 0.f, 0.f};
        cur = nxt; cA = nA; cB = nB; ++ui;
        if constexpr (ALIGN_EPI) { if (wr == 1) PG8_BAR; }
    }
    PG8_WAIT_V(0);
    if constexpr (!ALIGN_EPI) { if (wr == 0) PG8_BAR; }
    PG8_BAR;
    if constexpr (Epi::AFTER_DRAIN) { E.fused(acc, cur, wr, wc, fr, fq, lds, wid, lane); S.done(cur); }
#undef PG8_SA
#undef PG8_SB
#undef PG8_STAGE
#undef PG8_LDA
#undef PG8_LDB
#undef PG8_MMA
#undef PG8_WAIT_V
#undef PG8_WAIT_L
#undef PG8_BAR
#undef PG8_SCHED
}
}

#ifndef MK_N_LAUNCHES
#define MK_N_LAUNCHES 1
#endif
#define DI __device__ __forceinline__
#define LAS __attribute__((address_space(3)))
typedef unsigned short bf16_t;
typedef short bf16x8 __attribute__((ext_vector_type(8)));
typedef float f32x4 __attribute__((ext_vector_type(4)));
typedef float f32x16 __attribute__((ext_vector_type(16)));
typedef unsigned u32x4 __attribute__((ext_vector_type(4)));
typedef unsigned u32x2 __attribute__((ext_vector_type(2)));
typedef float f32x2_t __attribute__((ext_vector_type(2)));
typedef __bf16 bf16x2_t __attribute__((ext_vector_type(2)));

constexpr int DM = 1024, NBATCH = 4, SEQ = 8192, MROWS = NBATCH * SEQ, DIN = 2304, DFF = 2816, NGU = 2 * DFF;
constexpr float EPS = 1e-6f, LOG2E = 1.4426950408889634f, QSCALE = 0.125f * LOG2E;
constexpr int NPHASE = 6;
constexpr int NTHREADS = 512, NWAVES = 8;
constexpr int LDS_BYTES = 147456;

constexpr size_t MiB = 1u << 20;
constexpr size_t WS_WIN = 0, WS_WOUT = 5 * MiB, WS_WGU = 7 * MiB, WS_WDN = 18 * MiB, WS_ROPE = 24 * MiB, WS_SSQ1 = 25 * MiB, WS_SSQ2 = 27 * MiB;
constexpr size_t WS_GB = 29 * MiB, WS_UB = 51 * MiB;
constexpr size_t WS_XN = 64 * MiB, WS_MIX = 64 * MiB;
constexpr size_t WS_H1B = 128 * MiB;
constexpr size_t WS_QA = 192 * MiB, WS_KA = 224 * MiB, WS_VTA = 232 * MiB, WS_QB = 240 * MiB, WS_KB = 272 * MiB, WS_VTB = 304 * MiB;
constexpr size_t WS_ACT = 336 * MiB;
constexpr size_t WS_END = 512 * MiB;
static_assert(WS_ACT + (size_t)MROWS * DFF * 2 <= WS_END, "workspace map");
constexpr size_t WS_BAR = 24 * MiB + 768 * 1024;

DI unsigned cvtpk(float lo, float hi) { f32x2_t v = {lo, hi}; bf16x2_t b = __builtin_convertvector(v, bf16x2_t); return __builtin_bit_cast(unsigned, b); }
DI float wave_sum(float v) {
#pragma unroll
    for (int o = 1; o < 64; o <<= 1) v += __shfl_xor(v, o);
    return v;
}
DI float fexp2(float x) { return __builtin_amdgcn_exp2f(x); }
typedef __amdgpu_buffer_rsrc_t rsrc_t;
DI rsrc_t mk_rsrc(const void* base) { return __builtin_amdgcn_make_buffer_rsrc((void*)base, 0, 0x7ffffff0, 0x00020000); }
DI void st16_wt(rsrc_t r, unsigned byte_off, u32x4 v) { __builtin_amdgcn_raw_buffer_store_b128(v, r, (int)byte_off, 0, 16); }
template <int CTRL> DI float dpp_ror(float v) { return __builtin_bit_cast(float, __builtin_amdgcn_update_dpp(0, __builtin_bit_cast(int, v), CTRL, 0xf, 0xf, false)); }

#define XB_TMO      128
#define XB_XCNT(j)  (256  + 64 * (j))
#define XB_XSUB(j)  (1280 + 64 * (j))
#define XB_XGEN(j)  (2304 + 64 * (j))
#define XB_TOP      3328
#define XB_TOPGEN   3392
#define XCD_BAR_WORDS 3456
#define XB_SPIN_CAP (1u << 18)

__device__ __forceinline__ unsigned xb_ld(unsigned* p)              { return __hip_atomic_load(p, __ATOMIC_RELAXED, __HIP_MEMORY_SCOPE_AGENT); }
__device__ __forceinline__ unsigned xb_add(unsigned* p, unsigned v) { return __hip_atomic_fetch_add(p, v, __ATOMIC_RELAXED, __HIP_MEMORY_SCOPE_AGENT); }
__device__ __forceinline__ unsigned xb_xcc_id() { return (unsigned)__builtin_amdgcn_s_getreg((3 << 11) | 20) & 0xFu; }
#define XB_SPIN(cond, bar) do { unsigned _sp = 0; while (cond) { __builtin_amdgcn_s_sleep(1); \
    if ((++_sp & 255u) == 0u) { if (xb_ld(&(bar)[XB_TMO])) break; if (_sp > XB_SPIN_CAP) { atomicAdd(&(bar)[XB_TMO], 1u); break; } } } } while (0)

struct XcdBarrier {
    unsigned* bar; unsigned x;
    volatile LAS unsigned* st;
};

__device__ __forceinline__ XcdBarrier xcd_barrier_post(unsigned* bar, volatile LAS unsigned* st) {
    XcdBarrier b; b.bar = bar; b.x = xb_xcc_id(); b.st = st;
    if (threadIdx.x == 0) (void)xb_add(&bar[XB_XCNT(b.x)], 1u);
    return b;
}
__device__ __forceinline__ void xcd_barrier_complete(unsigned* bar, unsigned x, unsigned& nloc, unsigned& nx) {
    const unsigned G = gridDim.x * gridDim.y * gridDim.z;
    unsigned sum, cnt, mine, sp = 0u;
    for (;;) {
        sum = 0u; cnt = 0u; mine = 0u;
#pragma unroll
        for (unsigned j = 0; j < 16; ++j) { const unsigned c = xb_ld(&bar[XB_XCNT(j)]); sum += c; cnt += (c > 0u) ? 1u : 0u; mine = (j == x) ? c : mine; }
        if (sum == G) break;
        __builtin_amdgcn_s_sleep(1);
        if ((++sp & 255u) == 0u) { if (xb_ld(&bar[XB_TMO])) break; if (sp > XB_SPIN_CAP) { atomicAdd(&bar[XB_TMO], 1u); break; } }
    }
    nloc = mine > 0u ? mine : 1u; nx = cnt > 0u ? cnt : 1u;
}

__device__ __forceinline__ void xcd_barrier(const XcdBarrier& b) {
    asm volatile("s_waitcnt vmcnt(0)" ::: "memory");
    __syncthreads();
    if (threadIdx.x == 0) {
        unsigned* bar = b.bar;
        __builtin_amdgcn_s_waitcnt(0);
        unsigned nloc = b.st[0], nx = b.st[1];
        if (nloc == 0u) { xcd_barrier_complete(bar, b.x, nloc, nx); b.st[0] = nloc; b.st[1] = nx; }
        const unsigned old = xb_add(&bar[XB_XSUB(b.x)], 1u);
        const unsigned gen = old / nloc;
        if (old + 1u == (gen + 1u) * nloc) {
            __builtin_amdgcn_fence(__ATOMIC_RELEASE, "agent");
            asm volatile("s_waitcnt vmcnt(0)" ::: "memory");
            const unsigned og = xb_add(&bar[XB_TOP], 1u);
            const unsigned tg = og / nx;
            if (og + 1u == (tg + 1u) * nx) xb_add(&bar[XB_TOPGEN], 1u);
            else XB_SPIN(xb_ld(&bar[XB_TOPGEN]) == tg, bar);
            __builtin_amdgcn_fence(__ATOMIC_ACQUIRE, "agent");
            xb_add(&bar[XB_XGEN(b.x)], 1u);
            asm volatile("s_waitcnt vmcnt(0)" ::: "memory");
        } else {
            XB_SPIN(xb_ld(&bar[XB_XGEN(b.x)]) == gen, bar);
            __builtin_amdgcn_fence(__ATOMIC_ACQUIRE, "agent");
            asm volatile("s_waitcnt vmcnt(0)" ::: "memory");
        }
    }
    __syncthreads();
}


template <int MODE, bool WT_THROUGH = false>
DI void p0_transpose_item(const float* __restrict__ W, int K, int N, bf16_t* __restrict__ WT, LAS float* scr, int item, int lane, const float* __restrict__ ks) {
    const int nblk = N / 32, kb = item / nblk, nb = item % nblk, k0 = 64 * kb, n0 = 32 * nb;
#pragma unroll 8
    for (int i = 0; i < 32; ++i) { const int kk = 2 * i + (lane >> 5); float v = W[(size_t)(k0 + kk) * N + n0 + (lane & 31)]; if (MODE != 0) v *= ks[k0 + kk]; scr[kk * 33 + (lane & 31)] = v; }
    asm volatile("s_waitcnt lgkmcnt(0)" ::: "memory");
    const int c = lane & 7;
    const int rbase = (MODE == 0) ? n0 : (256 * (n0 >> 7) + (n0 & 127) + (MODE == 2 ? 128 : 0));
#pragma unroll
    for (int j = 0; j < 4; ++j) { const int n = (lane >> 3) + 8 * j; const LAS float* s = scr + (8 * c) * 33 + n;
        u32x4 o; o.x = cvtpk(s[0 * 33], s[1 * 33]); o.y = cvtpk(s[2 * 33], s[3 * 33]); o.z = cvtpk(s[4 * 33], s[5 * 33]); o.w = cvtpk(s[6 * 33], s[7 * 33]);
        if (MODE == 0 && !WT_THROUGH) *(u32x4*)(WT + (size_t)(rbase + n) * K + k0 + 8 * c) = o;
        else st16_wt(mk_rsrc(WT), (unsigned)(((rbase + n) * K + k0 + 8 * c) * 2), o); }
    asm volatile("s_waitcnt lgkmcnt(0)" ::: "memory");
}

struct Ptrs {
    const float *x, *norm_mix, *w_in, *sink, *rpb, *norm_a, *norm_b, *w_out, *norm_ffn, *w_gate, *w_up, *conv_w, *conv_b, *w_down, *norm_final;
    float* out; unsigned char* ws;
};

DI void phase0_local(const Ptrs& P, LAS unsigned char* lds, int vcu, int G, int wave, int lane, int tid, unsigned* wcnt) {
    LAS float* scr = (LAS float*)(lds + wave * 16384);
    const int gw = vcu * NWAVES + wave, NGW = G * NWAVES;
    bf16_t* WIN = (bf16_t*)(P.ws + WS_WIN); bf16_t* WOUT = (bf16_t*)(P.ws + WS_WOUT);
    constexpr int I_IN = (DM / 64) * (DIN / 32), I_OUT = (DM / 64) * (DM / 32);
    for (int it = gw; it < I_IN + I_OUT; it += NGW) {
        int r = it;
        if (r < I_IN) { p0_transpose_item<0, true>(P.w_in, DM, DIN, WIN, scr, r, lane, nullptr); continue; } r -= I_IN;
        p0_transpose_item<0, true>(P.w_out, DM, DM, WOUT, scr, r, lane, nullptr);
    }
    float* rope = (float*)(P.ws + WS_ROPE);
    for (int idx = vcu * NTHREADS + tid; idx < SEQ * 8; idx += G * NTHREADS) {
        const int pos = idx >> 3, i = idx & 7;
        const double inv = i == 0 ? 1.0 : i == 1 ? 0.19392274474868576 : i == 2 ? 0.03760603093086393 : i == 3 ? 0.007292664737217109 : i == 4 ? 0.001414213562373095
                         : i == 5 ? 0.0002742481756762073 : i == 6 ? 5.318295896944988e-05 : 1.031338537721246e-05;
        const double t = (double)pos * inv * 0.15915494309189535;
        const float fr = (float)(t - (double)(long long)t);
        __hip_atomic_store(rope + pos * 16 + i, __builtin_amdgcn_cosf(fr), __ATOMIC_RELAXED, __HIP_MEMORY_SCOPE_AGENT);
        __hip_atomic_store(rope + pos * 16 + 8 + i, __builtin_amdgcn_sinf(fr), __ATOMIC_RELAXED, __HIP_MEMORY_SCOPE_AGENT);
    }
    asm volatile("s_waitcnt vmcnt(0)" ::: "memory"); __syncthreads();
    if (tid == 0) __hip_atomic_fetch_add(wcnt, 1u, __ATOMIC_RELAXED, __HIP_MEMORY_SCOPE_AGENT);
    bf16_t* XN = (bf16_t*)(P.ws + WS_XN);
    f32x4 gm[4];
#pragma unroll
    for (int j = 0; j < 4; ++j) gm[j] = ((const f32x4*)P.norm_mix)[lane + 64 * j];
    for (int k = 0; k < 16; k += 2) {
        const int m0 = vcu * 128 + wave + 8 * k, m1 = m0 + 8;
        const f32x4* xr0 = (const f32x4*)(P.x + (size_t)m0 * DM) + lane; const f32x4* xr1 = (const f32x4*)(P.x + (size_t)m1 * DM) + lane;
        f32x4 v0[4], v1[4]; float s0 = 0.f, s1 = 0.f;
#pragma unroll
        for (int j = 0; j < 4; ++j) { v0[j] = xr0[64 * j]; v1[j] = xr1[64 * j]; }
#pragma unroll
        for (int j = 0; j < 4; ++j) { s0 += (v0[j].x * v0[j].x + v0[j].y * v0[j].y) + (v0[j].z * v0[j].z + v0[j].w * v0[j].w); s1 += (v1[j].x * v1[j].x + v1[j].y * v1[j].y) + (v1[j].z * v1[j].z + v1[j].w * v1[j].w); }
        const float rs0 = rsqrtf(wave_sum(s0) * (1.f / DM) + EPS), rs1 = rsqrtf(wave_sum(s1) * (1.f / DM) + EPS);
        u32x2* o0 = (u32x2*)(XN + (size_t)m0 * DM) + lane; u32x2* o1 = (u32x2*)(XN + (size_t)m1 * DM) + lane;
#pragma unroll
        for (int j = 0; j < 4; ++j) { u32x2 w; w.x = cvtpk(v0[j].x * rs0 * gm[j].x, v0[j].y * rs0 * gm[j].y); w.y = cvtpk(v0[j].z * rs0 * gm[j].z, v0[j].w * rs0 * gm[j].w); o0[64 * j] = w;
            u32x2 w1; w1.x = cvtpk(v1[j].x * rs1 * gm[j].x, v1[j].y * rs1 * gm[j].y); w1.y = cvtpk(v1[j].z * rs1 * gm[j].z, v1[j].w * rs1 * gm[j].w); o1[64 * j] = w1; }
    }
}
DI void phase0(const Ptrs& P, LAS unsigned char* lds, int vcu, int G, int wave, int lane, int tid) {
    LAS float* scr = (LAS float*)(lds + wave * 16384);
    const int gw = vcu * NWAVES + wave, NGW = G * NWAVES;
    bf16_t* WIN = (bf16_t*)(P.ws + WS_WIN); bf16_t* WOUT = (bf16_t*)(P.ws + WS_WOUT); bf16_t* WGU = (bf16_t*)(P.ws + WS_WGU); bf16_t* WDN = (bf16_t*)(P.ws + WS_WDN);
    constexpr int I_IN = (DM / 64) * (DIN / 32), I_OUT = (DM / 64) * (DM / 32), I_G = (DM / 64) * (DFF / 32), I_D = (DFF / 64) * (DM / 32);
    constexpr int NITEMS = I_IN + I_OUT + 2 * I_G + I_D;
    (void)WGU; (void)WDN; (void)NITEMS;
    for (int it = gw; it < I_IN + I_OUT; it += NGW) {
        int r = it;
        if (r < I_IN) { p0_transpose_item<0>(P.w_in, DM, DIN, WIN, scr, r, lane, nullptr); continue; } r -= I_IN;
        p0_transpose_item<0>(P.w_out, DM, DM, WOUT, scr, r, lane, nullptr);
    }
    bf16_t* XN = (bf16_t*)(P.ws + WS_XN);
    f32x4 gm[4];
#pragma unroll
    for (int j = 0; j < 4; ++j) gm[j] = ((const f32x4*)P.norm_mix)[lane + 64 * j];
    for (int m = gw; m < MROWS; m += NGW) {
        const f32x4* xr = (const f32x4*)(P.x + (size_t)m * DM) + lane;
        f32x4 v[4]; float s = 0.f;
#pragma unroll
        for (int j = 0; j < 4; ++j) { v[j] = xr[64 * j]; s += (v[j].x * v[j].x + v[j].y * v[j].y) + (v[j].z * v[j].z + v[j].w * v[j].w); }
        const float rs = rsqrtf(wave_sum(s) * (1.f / DM) + EPS);
        u32x2* o8 = (u32x2*)(XN + (size_t)m * DM) + lane;
#pragma unroll
        for (int j = 0; j < 4; ++j) { u32x2 w; w.x = cvtpk(v[j].x * rs * gm[j].x, v[j].y * rs * gm[j].y); w.y = cvtpk(v[j].z * rs * gm[j].z, v[j].w * rs * gm[j].w); o8[64 * j] = w; }
    }
    float* rope = (float*)(P.ws + WS_ROPE);
    for (int idx = vcu * NTHREADS + tid; idx < SEQ * 8; idx += G * NTHREADS) {
        const int pos = idx >> 3, i = idx & 7;
        const double inv = i == 0 ? 1.0 : i == 1 ? 0.19392274474868576 : i == 2 ? 0.03760603093086393 : i == 3 ? 0.007292664737217109 : i == 4 ? 0.001414213562373095
                         : i == 5 ? 0.0002742481756762073 : i == 6 ? 5.318295896944988e-05 : 1.031338537721246e-05;
        const double t = (double)pos * inv * 0.15915494309189535;
        const float fr = (float)(t - (double)(long long)t);
        rope[pos * 16 + i] = __builtin_amdgcn_cosf(fr);
        rope[pos * 16 + 8 + i] = __builtin_amdgcn_sinf(fr);
    }
}

DI void ffn_weights(const Ptrs& P, LAS unsigned char* lds, int part, int nparts, int wave, int lane) {
    LAS float* scr = (LAS float*)(lds + wave * 16384);
    bf16_t* WGU = (bf16_t*)(P.ws + WS_WGU); bf16_t* WDN = (bf16_t*)(P.ws + WS_WDN);
    constexpr int I_G = (DM / 64) * (DFF / 32), I_D = (DFF / 64) * (DM / 32);
    for (int it = part * NWAVES + wave; it < 2 * I_G + I_D; it += nparts * NWAVES) {
        int r = it;
        if (r < I_G) { p0_transpose_item<1>(P.w_gate, DM, DFF, WGU, scr, r, lane, P.norm_ffn); continue; } r -= I_G;
        if (r < I_G) { p0_transpose_item<2>(P.w_up, DM, DFF, WGU, scr, r, lane, P.norm_ffn); continue; } r -= I_G;
        p0_transpose_item<0, true>(P.w_down, DFF, DM, WDN, scr, r, lane, nullptr);
    }
    asm volatile("s_waitcnt vmcnt(0)" ::: "memory"); __syncthreads();
    if (threadIdx.x == 0) __hip_atomic_fetch_add((unsigned*)(P.ws + WS_BAR + 114688), 1u, __ATOMIC_RELAXED, __HIP_MEMORY_SCOPE_AGENT);
}

struct OrdOrder { pg8::StaticOrder S;
    DI bool next(int i, pg8::Unit& u) const { u.ord = i; return S.next(i, u); }
    DI void a_ready(const pg8::Unit&) const {} DI void done(const pg8::Unit&) const {} };
struct QuadOrder { int j, q, nN;
    DI bool next(int i, pg8::Unit& u) const {
        u.ord = i;
        if (nN == 4) { if (i >= 2) return false; u.pm = 2 * j + i; u.pn = q; return true; }
        const int e = 4 * i + q; if (e >= 2 * nN) return false;
        const int hi = e >= nN ? 1 : 0; u.pm = 2 * j + hi; u.pn = e - hi * nN; return true; }
    DI void a_ready(const pg8::Unit&) const {} DI void done(const pg8::Unit&) const {} };
DI void quad_sync(unsigned* flags, int vcu, int nquads, unsigned seq, int with_nb, int tid) {
    asm volatile("s_waitcnt vmcnt(0)" ::: "memory"); __syncthreads();
    if (tid < 64) {
        const int j = vcu >> 2; const unsigned myx = xb_xcc_id() + 1u;
        const int lo = ((with_nb & 1) ? max(j - 1, 0) : j) * 4, hi = ((with_nb & 2) ? min(j + 2, nquads) : j + 1) * 4;
        const int w = lo + tid; const bool act = w < hi;
        const unsigned px = act ? xb_ld(&flags[64 * w + 1]) : myx;
        if (!__all(px == myx)) { __builtin_amdgcn_fence(__ATOMIC_RELEASE, "agent"); asm volatile("s_waitcnt vmcnt(0)" ::: "memory"); }
        if (tid == 0) __hip_atomic_store(&flags[64 * vcu], seq, __ATOMIC_RELAXED, __HIP_MEMORY_SCOPE_AGENT);
        unsigned sp = 0;
        for (;;) { const unsigned v = act ? xb_ld(&flags[64 * w]) : seq; if (__all(v >= seq) || ++sp > (1u << 22)) break; __builtin_amdgcn_s_sleep(1); }
        __builtin_amdgcn_fence(__ATOMIC_ACQUIRE, "agent"); asm volatile("s_waitcnt vmcnt(0)" ::: "memory");
    }
    __syncthreads();
}
constexpr int RS_OFF = 131072 + 1024, RS_MAXU = 14;

struct EpiProj {
    static constexpr bool PERM = true, AFTER_DRAIN = false;
    bf16_t *QA, *KA, *VTA, *QB, *KB, *VTB; const float* rope;
    DI void operator()(const pg8::f32x4 (&acc)[2][2][4][2], const pg8::Unit& u, int wr, int wc, int fr, int fq) const {
        const int lane16 = fr + 16 * fq; (void)lane16;
        const int row0 = u.pm * 256 + wr * 64 + fr;
#pragma unroll
        for (int bj = 0; bj < 2; ++bj) {
            const int colbase = u.pn * 256 + bj * 128;
            const int cl = wc * 32 + fq * 8;
            int kind, c0, pitch; bf16_t* dst;
            if (colbase < 512)       { kind = 0; c0 = colbase;        dst = QA; pitch = 512; }
            else if (colbase < 640)  { kind = 1; c0 = colbase - 512;  dst = KA; pitch = 128; }
            else if (colbase < 768)  { kind = 2; c0 = colbase - 640;  dst = VTA; pitch = 0; }
            else if (colbase < 1280) { kind = 3; c0 = colbase - 768;  dst = QB; pitch = 512; }
            else if (colbase < 1792) { kind = 4; c0 = colbase - 1280; dst = KB; pitch = 512; }
            else                     { kind = 5; c0 = colbase - 1792; dst = VTB; pitch = 0; }
            const bool rope_w = (kind <= 1) && ((wc & 1) == 0);
            const float sc = (kind == 0 || kind == 3) ? QSCALE : 1.f;
#pragma unroll
            for (int ai = 0; ai < 2; ++ai)
#pragma unroll
                for (int m = 0; m < 4; ++m) {
                    const int row = row0 + ai * 128 + m * 16;
                    f32x4 v0 = acc[ai][bj][m][0], v1 = acc[ai][bj][m][1];
                    if (rope_w) {
                        const int pos = row & (SEQ - 1);
                        const f32x4 c0v = *(const f32x4*)(rope + pos * 16), c1v = *(const f32x4*)(rope + pos * 16 + 4);
                        const f32x4 s0v = *(const f32x4*)(rope + pos * 16 + 8), s1v = *(const f32x4*)(rope + pos * 16 + 12);
                        f32x4 p0, p1;
#pragma unroll
                        for (int j = 0; j < 4; ++j) { p0[j] = __shfl_xor(v0[j], 16); p1[j] = __shfl_xor(v1[j], 16); }
                        if (fq == 0) { v0 = v0 * c0v - p0 * s0v; v1 = v1 * c1v - p1 * s1v; }
                        else if (fq == 1) { v0 = v0 * c0v + p0 * s0v; v1 = v1 * c1v + p1 * s1v; }
                    }
                    v0 = v0 * sc; v1 = v1 * sc;
                    if (kind == 2 || kind == 5) {
                        const int b = row >> 13, s = row & (SEQ - 1);
                        const int cc = c0 + cl, head = cc >> 6, dim0 = cc & 63, nh = (kind == 2) ? 2 : 8;
                        bf16_t* vp = dst + (((size_t)(b * nh + head) * (SEQ / 8) + (s >> 3)) * 64 + dim0) * 8 + (s & 7);
#pragma unroll
                        for (int j = 0; j < 4; ++j) { vp[8 * j] = (bf16_t)(cvtpk(v0[j], 0.f) & 0xffffu); vp[8 * (4 + j)] = (bf16_t)(cvtpk(v1[j], 0.f) & 0xffffu); }
                    } else if (kind == 1 || kind == 4) {
                        const int b = row >> 13, s = row & (SEQ - 1);
                        const int cc = c0 + cl, head = cc >> 6, chunk = (cc & 63) >> 3, nh = (kind == 1) ? 2 : 8;
                        u32x4 w; w.x = cvtpk(v0[0], v0[1]); w.y = cvtpk(v0[2], v0[3]); w.z = cvtpk(v1[0], v1[1]); w.w = cvtpk(v1[2], v1[3]);
                        *(u32x4*)(dst + (((size_t)(b * nh + head) * 8 + chunk) * SEQ + s) * 8) = w;
                    } else {
                        u32x4 w; w.x = cvtpk(v0[0], v0[1]); w.y = cvtpk(v0[2], v0[3]); w.z = cvtpk(v1[0], v1[1]); w.w = cvtpk(v1[2], v1[3]);
                        *(u32x4*)(dst + (size_t)row * pitch + c0 + cl) = w;
                    }
                }
        }
    }
};

struct EpiOut {
    static constexpr bool PERM = true, AFTER_DRAIN = false;
    const float* x; bf16_t* h1b; float* ssq;
    DI void operator()(const pg8::f32x4 (&acc)[2][2][4][2], const pg8::Unit& u, int wr, int wc, int fr, int fq) const {
        const int row0 = u.pm * 256 + wr * 64 + fr;
#pragma unroll
        for (int ai = 0; ai < 2; ++ai)
#pragma unroll
            for (int m = 0; m < 4; ++m) {
                const int row = row0 + ai * 128 + m * 16; float ss = 0.f;
#pragma unroll
                for (int bj = 0; bj < 2; ++bj) {
                    const size_t off = (size_t)row * DM + u.pn * 256 + bj * 128 + wc * 32 + 8 * fq;
                    const f32x4 v0 = acc[ai][bj][m][0] + *(const f32x4*)(x + off), v1 = acc[ai][bj][m][1] + *(const f32x4*)(x + off + 4);
                    u32x4 w; w.x = cvtpk(v0[0], v0[1]); w.y = cvtpk(v0[2], v0[3]); w.z = cvtpk(v1[0], v1[1]); w.w = cvtpk(v1[2], v1[3]);
                    *(u32x4*)(h1b + off) = w;
                    ss += (v0[0] * v0[0] + v0[1] * v0[1]) + (v0[2] * v0[2] + v0[3] * v0[3]) + (v1[0] * v1[0] + v1[1] * v1[1]) + (v1[2] * v1[2] + v1[3] * v1[3]);
                }
                ss += __shfl_xor(ss, 16); ss += __shfl_xor(ss, 32);
                if (fq == 0) ssq[(size_t)row * 16 + u.pn * 4 + wc] = ss;
            }
    }
};

struct EpiGU {
    static constexpr bool PERM = true, AFTER_DRAIN = false;
    const LAS float* rsl; const float* cw; const float* cb; bf16_t* act; float* gb; float* ub;
    DI void operator()(const pg8::f32x4 (&acc)[2][2][4][2], const pg8::Unit& u, int wr, int wc, int fr, int fq) const {
        const int lane = fr + 16 * fq;
        const int f0 = u.pn * 128 + wc * 32 + 8 * fq;
        f32x4 w0[2], w1[2], w2[2], bb[2];
#pragma unroll
        for (int n = 0; n < 2; ++n) { w0[n] = *(const f32x4*)(cw + f0 + 4 * n); w1[n] = *(const f32x4*)(cw + DFF + f0 + 4 * n); w2[n] = *(const f32x4*)(cw + 2 * DFF + f0 + 4 * n); bb[n] = *(const f32x4*)(cb + f0 + 4 * n); }
#pragma unroll
        for (int ai = 0; ai < 2; ++ai) {
            const int rowb = u.pm * 256 + ai * 128 + wr * 64;
            const int blk64 = rowb >> 6;
            float rsv[4];
#pragma unroll
            for (int m = 0; m < 4; ++m) {
                rsv[m] = rsl[u.ord * 256 + ai * 128 + wr * 64 + 16 * m + fr];
            }
#pragma unroll
            for (int n = 0; n < 2; ++n) {
                f32x4 g[4], R[4], L[4];
#pragma unroll
                for (int m = 0; m < 4; ++m) { g[m] = acc[ai][0][m][n] * rsv[m];
#pragma unroll
                    for (int j = 0; j < 4; ++j) { R[m][j] = dpp_ror<0x121>(g[m][j]); L[m][j] = dpp_ror<0x12F>(g[m][j]); } }
#pragma unroll
                for (int m = 0; m < 4; ++m) {
                    const int row = rowb + 16 * m + fr;
                    const f32x4 uu = acc[ai][1][m][n] * rsv[m];
                    const f32x4 zero = {0.f, 0.f, 0.f, 0.f};
                    const f32x4 prev = (fr > 0) ? R[m] : (m > 0 ? R[m > 0 ? m - 1 : 0] : zero);
                    const f32x4 next = (fr < 15) ? L[m] : (m < 3 ? L[m < 3 ? m + 1 : 3] : zero);
                    const f32x4 cv = w0[n] * prev + w1[n] * g[m] + w2[n] * next + bb[n];
                    f32x4 a;
#pragma unroll
                    for (int j = 0; j < 4; ++j) a[j] = cv[j] * __builtin_amdgcn_rcpf(1.f + fexp2(-LOG2E * cv[j])) * uu[j];
                    u32x2 wv; wv.x = cvtpk(a[0], a[1]); wv.y = cvtpk(a[2], a[3]);
                    if (m == 0 && fr < 2) *(f32x4*)(gb + ((size_t)(blk64 * 4 + fr)) * DFF + f0 + 4 * n) = g[m];
                    if (m == 3 && fr >= 14) *(f32x4*)(gb + ((size_t)(blk64 * 4 + fr - 12)) * DFF + f0 + 4 * n) = g[m];
                    if (m == 0 && fr == 0) *(f32x4*)(ub + ((size_t)(blk64 * 2 + 0)) * DFF + f0 + 4 * n) = uu;
                    if (m == 3 && fr == 15) *(f32x4*)(ub + ((size_t)(blk64 * 2 + 1)) * DFF + f0 + 4 * n) = uu;
                    const bool edge = (m == 0 && fr == 0) || (m == 3 && fr == 15);
                    if (!edge) *(u32x2*)(act + (size_t)row * DFF + f0 + 4 * n) = wv;
                }
            }
        }
    }
};

struct EpiDownNorm {
    static constexpr bool PERM = true, AFTER_DRAIN = false;
    const bf16_t* h1b; float* out; const float* gfin; float* ssq2; unsigned* cnt;
    DI void operator()(pg8::f32x4 (&acc)[2][2][4][2], const pg8::Unit& u, int wr, int wc, int fr, int fq) const {
        const int row0 = u.pm * 256 + wr * 64 + fr;
#pragma unroll
        for (int ai = 0; ai < 2; ++ai)
#pragma unroll
            for (int m = 0; m < 4; ++m) {
                const int row = row0 + ai * 128 + m * 16; float ss = 0.f;
#pragma unroll
                for (int bj = 0; bj < 2; ++bj) {
                    const size_t off = (size_t)row * DM + u.pn * 256 + bj * 128 + wc * 32 + 8 * fq;
                    const u32x4 hb = *(const u32x4*)(h1b + off);
                    f32x4 r0, r1;
                    r0[0] = __uint_as_float(hb.x << 16); r0[1] = __uint_as_float(hb.x & 0xffff0000u); r0[2] = __uint_as_float(hb.y << 16); r0[3] = __uint_as_float(hb.y & 0xffff0000u);
                    r1[0] = __uint_as_float(hb.z << 16); r1[1] = __uint_as_float(hb.z & 0xffff0000u); r1[2] = __uint_as_float(hb.w << 16); r1[3] = __uint_as_float(hb.w & 0xffff0000u);
                    const f32x4 v0 = acc[ai][bj][m][0] + r0, v1 = acc[ai][bj][m][1] + r1;
                    acc[ai][bj][m][0] = v0; acc[ai][bj][m][1] = v1;
                    ss += (v0[0] * v0[0] + v0[1] * v0[1]) + (v0[2] * v0[2] + v0[3] * v0[3]) + (v1[0] * v1[0] + v1[1] * v1[1]) + (v1[2] * v1[2] + v1[3] * v1[3]);
                }
                ss += __shfl_xor(ss, 16); ss += __shfl_xor(ss, 32);
                if (fq == 0) __hip_atomic_store(ssq2 + ((size_t)u.pn * MROWS + row) * 4 + wc, ss, __ATOMIC_RELAXED, __HIP_MEMORY_SCOPE_AGENT);
            }
        asm volatile("s_waitcnt vmcnt(0)" ::: "memory");
        __builtin_amdgcn_s_barrier(); asm volatile("" ::: "memory");
        if (__builtin_amdgcn_readfirstlane(threadIdx.x >> 6) == 0) {
            unsigned* c = cnt + 64 * u.pm;
            if ((fr | fq) == 0) __hip_atomic_fetch_add(c, 1u, __ATOMIC_RELAXED, __HIP_MEMORY_SCOPE_AGENT);
            unsigned spins = 0;
            while ((unsigned)__builtin_amdgcn_readfirstlane(__hip_atomic_load(c, __ATOMIC_RELAXED, __HIP_MEMORY_SCOPE_AGENT)) < 4u) { __builtin_amdgcn_s_sleep(2); if (++spins > (1u << 22)) break; }
        }
        asm volatile("s_waitcnt vmcnt(0) lgkmcnt(0)" ::: "memory"); __builtin_amdgcn_s_barrier(); asm volatile("" ::: "memory");
#pragma unroll
        for (int ai = 0; ai < 2; ++ai)
#pragma unroll
            for (int m = 0; m < 4; ++m) {
                const int row = row0 + ai * 128 + m * 16;
                const unsigned long long* pp = (const unsigned long long*)(ssq2 + ((size_t)fq * MROWS + row) * 4);
                const unsigned long long pa = __hip_atomic_load(pp, __ATOMIC_RELAXED, __HIP_MEMORY_SCOPE_AGENT), pb = __hip_atomic_load(pp + 1, __ATOMIC_RELAXED, __HIP_MEMORY_SCOPE_AGENT);
                float t = (__uint_as_float((unsigned)pa) + __uint_as_float((unsigned)(pa >> 32))) + (__uint_as_float((unsigned)pb) + __uint_as_float((unsigned)(pb >> 32)));
                t += __shfl_xor(t, 16); t += __shfl_xor(t, 32);
                const float rs = rsqrtf(t * (1.f / DM) + EPS);
#pragma unroll
                for (int bj = 0; bj < 2; ++bj) {
                    const int col0 = u.pn * 256 + bj * 128 + wc * 32 + 8 * fq;
                    const size_t off = (size_t)row * DM + col0;
                    const f32x4 g0 = *(const f32x4*)(gfin + col0), g1 = *(const f32x4*)(gfin + col0 + 4);
                    *(f32x4*)(out + off) = acc[ai][bj][m][0] * rs * g0; *(f32x4*)(out + off + 4) = acc[ai][bj][m][1] * rs * g1;
                }
            }
    }
};

#define MFMA32(a, b, c) __builtin_amdgcn_mfma_f32_32x32x16_bf16((a), (b), (c), 0, 0, 0)
DI int perm_key(int rho) { return (rho & ~12) | ((rho & 4) << 1) | ((rho & 8) >> 1); }
constexpr int RPB_PAD = 64, RPB_FLOATS = RPB_PAD + 8 * 480 + 64;

template <int MODE>
DI void attend(const bf16_t* __restrict__ Qg, const bf16_t* __restrict__ Kg, const bf16_t* __restrict__ VTg, int b, int blk, int h, int lane, float m_init,
               const LAS float* rpbL, LAS float* ssqbuf, const float* __restrict__ gain, bf16_t* __restrict__ mix) {
    const int q = lane & 31, hh = lane >> 5;
    constexpr int KP = MODE == 0 ? 128 : 512, NHV = MODE == 0 ? 2 : 8;
    const int hk = MODE == 0 ? (h >> 2) : h;
    const size_t tokb = (size_t)b * SEQ;
    const int t0 = 64 * blk;
    bf16x8 qf[2][4];
    { const bf16_t* qp = Qg + (tokb + t0 + q) * 512 + h * 64 + 8 * hh;
#pragma unroll
      for (int qt = 0; qt < 2; ++qt)
#pragma unroll
          for (int t = 0; t < 4; ++t) qf[qt][t] = *(const bf16x8*)(qp + (size_t)qt * 32 * 512 + 16 * t); }
    f32x16 o[2][2];
#pragma unroll
    for (int a = 0; a < 2; ++a)
#pragma unroll
        for (int c = 0; c < 2; ++c)
#pragma unroll
            for (int i = 0; i < 16; ++i) o[a][c][i] = 0.f;
    float mrow[2] = {m_init, m_init}, lsum[2];
    lsum[0] = lsum[1] = (MODE == 0 && hh == 0) ? 1.f : 0.f;
    int st_lo, st_hi, rs = 0;
    if (MODE == 0) { st_lo = max(0, 4 - 2 * blk); st_hi = min(10, 260 - 2 * blk); }
    else { rs = min(max(blk - 4, 0), 120); st_lo = 0; st_hi = 16; }
    const bf16_t* kbase = Kg + (((size_t)(b * NHV + hk) * 8 + hh) * SEQ + perm_key(q)) * 8;
    const bf16_t* vbase = VTg + (((size_t)(b * NHV + hk) * (SEQ / 8) + hh) * 64 + q) * 8;
#define WTOK(st) (MODE == 0 ? (t0 - 128 + 32 * (st)) : ((rs + ((st) >> 1)) * 64 + 32 * ((st) & 1)))
#define LOADKV(kd, vd, w) do { _Pragma("unroll") for (int t = 0; t < 4; ++t) kd[t] = *(const bf16x8*)(kbase + ((size_t)(2 * t) * SEQ + (w)) * 8); \
        _Pragma("unroll") for (int dt = 0; dt < 2; ++dt) _Pragma("unroll") for (int s2 = 0; s2 < 2; ++s2) vd[dt][s2] = *(const bf16x8*)(vbase + ((size_t)(((w) >> 3) + 2 * s2) * 64 + 32 * dt) * 8); } while (0)
    bf16x8 kc[4], vc[2][2];
    { const int w = WTOK(st_lo); LOADKV(kc, vc, w); }
    for (int st = st_lo; st < st_hi; ++st) {
        bf16x8 kn[4], vn[2][2];
        { const int stn = min(st + 1, st_hi - 1); const int wn = WTOK(stn); LOADKV(kn, vn, wn); }
        const int w = WTOK(st);
        f32x16 s[2];
#pragma unroll
        for (int qt = 0; qt < 2; ++qt) {
#pragma unroll
            for (int i = 0; i < 16; ++i) s[qt][i] = 0.f;
#pragma unroll
            for (int t = 0; t < 4; ++t) s[qt] = MFMA32(kc[t], qf[qt][t], s[qt]);
        }
        if (MODE == 0) {
            if (st < 2 || st >= 8) {
#pragma unroll
                for (int qt = 0; qt < 2; ++qt) { const int base = w + 8 * hh - (t0 + 32 * qt + q) + 128;
#pragma unroll
                    for (int i = 0; i < 16; ++i) { const int d = base + 16 * (i >> 3) + (i & 7); if ((unsigned)d > 256u) s[qt][i] = -INFINITY; } }
            }
        } else {
            const int c = st & 1, roff = rs + (st >> 1) - blk + 7;
#pragma unroll
            for (int qt = 0; qt < 2; ++qt) { const int qc = 32 * qt + q, cs = min(max(qc - 8, 0), 48), kb = 32 * c + 8 * hh;
                const LAS float* bp = rpbL + RPB_PAD + h * 480 + roff * 32 + kb - qc + 15;
#pragma unroll
                for (int i = 0; i < 16; ++i) { const int off = 16 * (i >> 3) + (i & 7); const int rel = kb + off - cs; const float bias = bp[off];
                    s[qt][i] = (s[qt][i] + bias) + (((unsigned)rel < 16u) ? 0.f : -INFINITY); } }
        }
        bf16x8 pf[2][2];
#pragma unroll
        for (int qt = 0; qt < 2; ++qt) {
            float mx = s[qt][0];
#pragma unroll
            for (int i = 1; i < 16; ++i) mx = fmaxf(mx, s[qt][i]);
            if (__any(mx > mrow[qt] + 8.f)) {
                mx = fmaxf(mx, __shfl_xor(mx, 32));
                const float mnew2 = fmaxf(mrow[qt], mx), alpha = fexp2(mrow[qt] - mnew2);
                mrow[qt] = mnew2; lsum[qt] *= alpha;
#pragma unroll
                for (int i = 0; i < 16; ++i) { o[0][qt][i] *= alpha; o[1][qt][i] *= alpha; }
            }
            const float mnew = mrow[qt];
            float rsum = 0.f;
#pragma unroll
            for (int i = 0; i < 16; ++i) { const float p = fexp2(s[qt][i] - mnew); s[qt][i] = p; rsum += p; }
            lsum[qt] += rsum;
#pragma unroll
            for (int s2 = 0; s2 < 2; ++s2) { u32x4 pk; pk.x = cvtpk(s[qt][8 * s2 + 0], s[qt][8 * s2 + 1]); pk.y = cvtpk(s[qt][8 * s2 + 2], s[qt][8 * s2 + 3]);
                pk.z = cvtpk(s[qt][8 * s2 + 4], s[qt][8 * s2 + 5]); pk.w = cvtpk(s[qt][8 * s2 + 6], s[qt][8 * s2 + 7]); pf[qt][s2] = __builtin_bit_cast(bf16x8, pk); }
        }
#pragma unroll
        for (int dt = 0; dt < 2; ++dt)
#pragma unroll
            for (int qt = 0; qt < 2; ++qt)
#pragma unroll
                for (int s2 = 0; s2 < 2; ++s2) o[dt][qt] = MFMA32(vc[dt][s2], pf[qt][s2], o[dt][qt]);
#pragma unroll
        for (int t = 0; t < 4; ++t) kc[t] = kn[t];
#pragma unroll
        for (int dt = 0; dt < 2; ++dt)
#pragma unroll
            for (int s2 = 0; s2 < 2; ++s2) vc[dt][s2] = vn[dt][s2];
    }
#undef WTOK
#undef LOADKV
#pragma unroll
    for (int qt = 0; qt < 2; ++qt) {
        const float l = lsum[qt] + __shfl_xor(lsum[qt], 32), inv = 1.f / l;
        float ss = 0.f;
#pragma unroll
        for (int dt = 0; dt < 2; ++dt)
#pragma unroll
            for (int i = 0; i < 16; ++i) { const float v = o[dt][qt][i] * inv; o[dt][qt][i] = v; ss += v * v; }
        ss += __shfl_xor(ss, 32);
        if (hh == 0) ssqbuf[h * 64 + 32 * qt + q] = ss;
    }
    __syncthreads();
#pragma unroll
    for (int qt = 0; qt < 2; ++qt) {
        float tot = 0.f;
#pragma unroll
        for (int h2 = 0; h2 < 8; ++h2) tot += ssqbuf[h2 * 64 + 32 * qt + q];
        const float rsn = rsqrtf(tot * (1.f / 512.f) + EPS);
        bf16_t* mp = mix + (tokb + t0 + 32 * qt + q) * DM + h * 64 + 4 * hh;
#pragma unroll
        for (int dt = 0; dt < 2; ++dt)
#pragma unroll
            for (int g = 0; g < 4; ++g) {
                const f32x4 gv = *(const f32x4*)(gain + h * 64 + 32 * dt + 8 * g + 4 * hh);
                u32x2 w; w.x = cvtpk(o[dt][qt][4 * g + 0] * rsn * gv[0], o[dt][qt][4 * g + 1] * rsn * gv[1]);
                w.y = cvtpk(o[dt][qt][4 * g + 2] * rsn * gv[2], o[dt][qt][4 * g + 3] * rsn * gv[3]);
                *(u32x2*)(mp + 32 * dt + 8 * g) = w;
            }
    }
}

#define MFMA16(a, b, c) __builtin_amdgcn_mfma_f32_16x16x32_bf16((a), (b), (c), 0, 0, 0)
template <int MODE>
DI void attend16(const bf16_t* __restrict__ Qg, const bf16_t* __restrict__ Kg, const bf16_t* __restrict__ VTg, int b, int blk, int h, int lane, float sink2,
                 const LAS float* rpbL, LAS float* ssqbuf, const float* __restrict__ gain, bf16_t* __restrict__ mix) {
    constexpr int NG = MODE == 0 ? 9 : 8, BR = MODE == 0 ? 3 : 4, GS = MODE == 0 ? 32 : 64, NHV = MODE == 0 ? 2 : 8;
    const int ql = lane & 15, g = lane >> 4;
    const int hk = MODE == 0 ? (h >> 2) : h;
    const size_t tokb = (size_t)b * SEQ;
    const int t0 = 64 * blk;
    const int rs = min(max(blk - 4, 0), 120);
    bf16_t* mp0 = mix + (tokb + t0 + ql) * DM + h * 64 + 4 * g;
#pragma unroll
    for (int a = 0; a < 4; ++a) {
        const int wa = a == 0 ? 0 : a == 1 ? 8 : a == 2 ? 24 : 32;
        const int qc = 16 * a + ql;
        const int T0 = MODE == 0 ? (t0 + 16 * a - 128) : (rs * 64 + wa);
        bf16x8 qf[2];
        { const bf16_t* qp = Qg + (tokb + t0 + qc) * 512 + h * 64 + 8 * g; qf[0] = *(const bf16x8*)qp; qf[1] = *(const bf16x8*)(qp + 32); }
        const bf16_t* kp = Kg + ((long)((b * NHV + hk) * 8 + g) * SEQ + T0 + 8 * (ql >> 2) + (ql & 3)) * 8;
        const bf16_t* vp = VTg + (((long)(b * NHV + hk) * (SEQ / 8) + T0 / 8 + g) * 64 + ql) * 8;
        float mk[8];
        const LAS float* bp = rpbL + RPB_PAD + h * 480 + (rs - blk + 7) * 32 + (wa + 8 * g - qc + 15);
        if (MODE == 1) { const int cs = min(max(qc - 8, 0), 48), relb = wa + 8 * g - cs;
#pragma unroll
            for (int si = 0; si < 8; ++si) mk[si] = ((unsigned)(relb + si) < 16u) ? 0.f : -INFINITY; }
        f32x4 s[NG][2];
        float mx = MODE == 0 ? sink2 : -INFINITY;
#pragma unroll
        for (int ib = 0; ib < NG; ib += BR) {
            bf16x8 kf[BR][2][2];
#pragma unroll
            for (int i4 = 0; i4 < BR; ++i4)
#pragma unroll
                for (int tau = 0; tau < 2; ++tau)
#pragma unroll
                    for (int t = 0; t < 2; ++t) kf[i4][tau][t] = *(const bf16x8*)(kp + ((long)(4 * t) * SEQ + (ib + i4) * GS + 4 * tau) * 8);
#pragma unroll
            for (int i4 = 0; i4 < BR; ++i4)
#pragma unroll
                for (int tau = 0; tau < 2; ++tau) {
                    const int i = ib + i4;
                    f32x4 z;
                    if (MODE == 1) {
#pragma unroll
                        for (int j = 0; j < 4; ++j) z[j] = bp[32 * i + 4 * tau + j] + mk[4 * tau + j];
                    } else {
#pragma unroll
                        for (int j = 0; j < 4; ++j) { const int key = T0 + 32 * i + 8 * g + 4 * tau + j; const int dd = 32 * i + 8 * g + 4 * tau + j - ql;
                            z[j] = ((unsigned)dd <= 256u && (unsigned)key < (unsigned)SEQ) ? 0.f : -INFINITY; }
                    }
                    z = MFMA16(kf[i4][tau][0], qf[0], z); z = MFMA16(kf[i4][tau][1], qf[1], z); s[i][tau] = z;
                    mx = fmaxf(mx, fmaxf(fmaxf(z[0], z[1]), fmaxf(z[2], z[3])));
                }
        }
        mx = fmaxf(mx, __shfl_xor(mx, 16)); mx = fmaxf(mx, __shfl_xor(mx, 32));
        float lsum = 0.f; bf16x8 pf[NG];
#pragma unroll
        for (int i = 0; i < NG; ++i) {
            float p[8];
#pragma unroll
            for (int tau = 0; tau < 2; ++tau)
#pragma unroll
                for (int j = 0; j < 4; ++j) { p[4 * tau + j] = fexp2(s[i][tau][j] - mx); lsum += p[4 * tau + j]; }
            u32x4 pk; pk.x = cvtpk(p[0], p[1]); pk.y = cvtpk(p[2], p[3]); pk.z = cvtpk(p[4], p[5]); pk.w = cvtpk(p[6], p[7]); pf[i] = __builtin_bit_cast(bf16x8, pk);
        }
        lsum += __shfl_xor(lsum, 16); lsum += __shfl_xor(lsum, 32);
        if (MODE == 0) lsum += fexp2(sink2 - mx);
        f32x4 oo[4];
#pragma unroll
        for (int d = 0; d < 4; ++d) oo[d] = (f32x4){0.f, 0.f, 0.f, 0.f};
#pragma unroll
        for (int ib = 0; ib < NG; ib += BR) {
            bf16x8 vf[BR][4];
#pragma unroll
            for (int i4 = 0; i4 < BR; ++i4)
#pragma unroll
                for (int d = 0; d < 4; ++d) vf[i4][d] = *(const bf16x8*)(vp + ((long)((ib + i4) * (GS / 8)) * 64 + 16 * d) * 8);
#pragma unroll
            for (int i4 = 0; i4 < BR; ++i4)
#pragma unroll
                for (int d = 0; d < 4; ++d) oo[d] = MFMA16(vf[i4][d], pf[ib + i4], oo[d]);
        }
        const float inv = 1.f / lsum;
        float ss = 0.f;
#pragma unroll
        for (int d = 0; d < 4; ++d) {
            const f32x4 v = oo[d] * inv;
            ss += (v[0] * v[0] + v[1] * v[1]) + (v[2] * v[2] + v[3] * v[3]);
            u32x2 w; w.x = cvtpk(v[0], v[1]); w.y = cvtpk(v[2], v[3]);
            *(u32x2*)(mp0 + (size_t)(16 * a) * DM + 16 * d) = w;
        }
        ss += __shfl_xor(ss, 16); ss += __shfl_xor(ss, 32);
        if (g == 0) ssqbuf[h * 64 + 16 * a + ql] = ss;
    }
    __syncthreads();
#pragma unroll
    for (int a = 0; a < 4; ++a) {
        float tot = 0.f;
#pragma unroll
        for (int h2 = 0; h2 < 8; ++h2) tot += ssqbuf[h2 * 64 + 16 * a + ql];
        const float rsn = rsqrtf(tot * (1.f / 512.f) + EPS);
#pragma unroll
        for (int d = 0; d < 4; ++d) {
            const f32x4 gv = *(const f32x4*)(gain + h * 64 + 16 * d + 4 * g);
            u32x2* p = (u32x2*)(mp0 + (size_t)(16 * a) * DM + 16 * d);
            const u32x2 r = *p;
            u32x2 w; w.x = cvtpk(__uint_as_float(r.x << 16) * rsn * gv[0], __uint_as_float(r.x & 0xffff0000u) * rsn * gv[1]);
            w.y = cvtpk(__uint_as_float(r.y << 16) * rsn * gv[2], __uint_as_float(r.y & 0xffff0000u) * rsn * gv[3]);
            *p = w;
        }
    }
}

DI bf16x8 scale_pf(bf16x8 p, float alpha) {
    const u32x4 r = __builtin_bit_cast(u32x4, p); u32x4 w;
    w.x = cvtpk(__uint_as_float(r.x << 16) * alpha, __uint_as_float(r.x & 0xffff0000u) * alpha); w.y = cvtpk(__uint_as_float(r.y << 16) * alpha, __uint_as_float(r.y & 0xffff0000u) * alpha);
    w.z = cvtpk(__uint_as_float(r.z << 16) * alpha, __uint_as_float(r.z & 0xffff0000u) * alpha); w.w = cvtpk(__uint_as_float(r.w << 16) * alpha, __uint_as_float(r.w & 0xffff0000u) * alpha);
    return __builtin_bit_cast(bf16x8, w);
}
template <int DELTA>
DI void attend_b_dual(const bf16_t* __restrict__ Qg, const bf16_t* __restrict__ Kg, const bf16_t* __restrict__ VTg, int b, int blk0, int h, int lane,
                      const LAS float* rpbL, LAS float* ssq0, LAS float* ssq1, bf16_t* __restrict__ mix) {
    constexpr int NR = 8 + DELTA, BR = DELTA ? 5 : 4;
    const int ql = lane & 15, g = lane >> 4;
    const int t0 = 64 * blk0;
    const int rs0 = min(max(blk0 - 4, 0), 120);
    bf16_t* mp0 = mix + ((size_t)b * SEQ + t0 + ql) * DM + h * 64 + 4 * g;
    const char* Kc = (const char*)Kg; const char* Vc = (const char*)VTg; const char* Qc = (const char*)Qg;
    const unsigned kb0 = (unsigned)(((((b * 8 + h) * 8 + g)) * SEQ + rs0 * 64 + 8 * (ql >> 2) + (ql & 3)) * 16);
    const unsigned vb0 = (unsigned)((((b * 8 + h) * (SEQ / 8) + rs0 * 8 + g) * 64 + ql) * 16);
    const unsigned qb0 = (unsigned)(((b * SEQ + t0 + ql) * 512 + h * 64 + 8 * g) * 2);
#pragma unroll
    for (int a = 0; a < 4; ++a) {
        const int wa = a == 0 ? 0 : a == 1 ? 8 : a == 2 ? 24 : 32;
        const int qc = 16 * a + ql;
        bf16x8 qf0[2], qf1[2];
        { unsigned q0_ = qb0; asm volatile("" : "+v"(q0_));
          qf0[0] = *(const bf16x8*)(Qc + (q0_ + (unsigned)(a * 16 * 1024))); qf0[1] = *(const bf16x8*)(Qc + (q0_ + (unsigned)(a * 16 * 1024 + 64)));
          qf1[0] = *(const bf16x8*)(Qc + (q0_ + (unsigned)((64 + a * 16) * 1024))); qf1[1] = *(const bf16x8*)(Qc + (q0_ + (unsigned)((64 + a * 16) * 1024 + 64))); }
        const int cs = min(max(qc - 8, 0), 48), relb = wa + 8 * g - cs;
        float mk[8];
#pragma unroll
        for (int si = 0; si < 8; ++si) mk[si] = ((unsigned)(relb + si) < 16u) ? 0.f : -INFINITY;
        const LAS float* bp0 = rpbL + RPB_PAD + h * 480 + (rs0 - blk0 + 7) * 32 + (wa + 8 * g - qc + 15);
        const LAS float* bp1 = bp0 + (DELTA - 1) * 32;
        float mref0 = -INFINITY, mref1 = -INFINITY, l0 = 0.f, l1 = 0.f; bf16x8 pf0[8], pf1[8];
#pragma unroll
        for (int ib = 0; ib < NR; ib += BR) {
            bf16x8 kf[BR][2][2];
            { unsigned k0_ = kb0; asm volatile("" : "+v"(k0_));
#pragma unroll
              for (int i4 = 0; i4 < BR; ++i4)
#pragma unroll
                  for (int tau = 0; tau < 2; ++tau)
#pragma unroll
                      for (int t = 0; t < 2; ++t) if (ib + i4 < NR) kf[i4][tau][t] = *(const bf16x8*)(Kc + (k0_ + (unsigned)(wa * 16 + (4 * t) * SEQ * 16 + ((ib + i4) * 64 + 4 * tau) * 16))); }
            f32x4 sa[BR][2], sb[BR][2];
            float bm0 = -INFINITY, bm1 = -INFINITY;
#pragma unroll
            for (int i4 = 0; i4 < BR; ++i4)
#pragma unroll
                for (int tau = 0; tau < 2; ++tau) {
                    const int iu = ib + i4, i1 = iu - DELTA;
                    if (iu < 8) { f32x4 z;
#pragma unroll
                        for (int j = 0; j < 4; ++j) z[j] = bp0[32 * iu + 4 * tau + j] + mk[4 * tau + j];
                        z = MFMA16(kf[i4][tau][0], qf0[0], z); z = MFMA16(kf[i4][tau][1], qf0[1], z); sa[i4][tau] = z; bm0 = fmaxf(bm0, fmaxf(fmaxf(z[0], z[1]), fmaxf(z[2], z[3]))); }
                    if (iu < NR && i1 >= 0 && i1 < 8) { f32x4 z;
#pragma unroll
                        for (int j = 0; j < 4; ++j) z[j] = bp1[32 * i1 + 4 * tau + j] + mk[4 * tau + j];
                        z = MFMA16(kf[i4][tau][0], qf1[0], z); z = MFMA16(kf[i4][tau][1], qf1[1], z); sb[i4][tau] = z; bm1 = fmaxf(bm1, fmaxf(fmaxf(z[0], z[1]), fmaxf(z[2], z[3]))); }
                }
            if (__any(bm0 > mref0 + 64.f)) {
                float m = fmaxf(bm0, __shfl_xor(bm0, 16)); m = fmaxf(m, __shfl_xor(m, 32)); m = fmaxf(m, mref0);
                const float alpha = fexp2(mref0 - m); mref0 = m; l0 *= alpha;
#pragma unroll
                for (int i = 0; i < 8; ++i) if (i < ib) pf0[i] = scale_pf(pf0[i], alpha);
            }
            if (__any(bm1 > mref1 + 64.f)) {
                float m = fmaxf(bm1, __shfl_xor(bm1, 16)); m = fmaxf(m, __shfl_xor(m, 32)); m = fmaxf(m, mref1);
                const float alpha = fexp2(mref1 - m); mref1 = m; l1 *= alpha;
#pragma unroll
                for (int i = 0; i < 8; ++i) if (i < ib - DELTA) pf1[i] = scale_pf(pf1[i], alpha);
            }
#pragma unroll
            for (int i4 = 0; i4 < BR; ++i4) {
                const int iu = ib + i4, i1 = iu - DELTA;
                if (iu < 8) { float p[8];
#pragma unroll
                    for (int tau = 0; tau < 2; ++tau)
#pragma unroll
                        for (int j = 0; j < 4; ++j) { p[4 * tau + j] = fexp2(sa[i4][tau][j] - mref0); l0 += p[4 * tau + j]; }
                    u32x4 pk; pk.x = cvtpk(p[0], p[1]); pk.y = cvtpk(p[2], p[3]); pk.z = cvtpk(p[4], p[5]); pk.w = cvtpk(p[6], p[7]); pf0[iu < 8 ? iu : 0] = __builtin_bit_cast(bf16x8, pk); }
                if (iu < NR && i1 >= 0 && i1 < 8) { float p[8];
#pragma unroll
                    for (int tau = 0; tau < 2; ++tau)
#pragma unroll
                        for (int j = 0; j < 4; ++j) { p[4 * tau + j] = fexp2(sb[i4][tau][j] - mref1); l1 += p[4 * tau + j]; }
                    u32x4 pk; pk.x = cvtpk(p[0], p[1]); pk.y = cvtpk(p[2], p[3]); pk.z = cvtpk(p[4], p[5]); pk.w = cvtpk(p[6], p[7]); pf1[(i1 >= 0 && i1 < 8) ? i1 : 0] = __builtin_bit_cast(bf16x8, pk); }
            }
        }
        l0 += __shfl_xor(l0, 16); l0 += __shfl_xor(l0, 32);
        l1 += __shfl_xor(l1, 16); l1 += __shfl_xor(l1, 32);
        f32x4 oo0[4], oo1[4];
#pragma unroll
        for (int d = 0; d < 4; ++d) { oo0[d] = (f32x4){0.f, 0.f, 0.f, 0.f}; oo1[d] = (f32x4){0.f, 0.f, 0.f, 0.f}; }
#pragma unroll
        for (int ib = 0; ib < NR; ib += BR) {
            bf16x8 vf[BR][4];
            { unsigned v0_ = vb0; asm volatile("" : "+v"(v0_));
#pragma unroll
              for (int i4 = 0; i4 < BR; ++i4)
#pragma unroll
                  for (int d = 0; d < 4; ++d) if (ib + i4 < NR) vf[i4][d] = *(const bf16x8*)(Vc + (v0_ + (unsigned)((wa / 8) * 1024 + ((ib + i4) * 8 * 64 + 16 * d) * 16))); }
#pragma unroll
            for (int i4 = 0; i4 < BR; ++i4) {
                const int iu = ib + i4, i1 = iu - DELTA;
#pragma unroll
                for (int d = 0; d < 4; ++d) {
                    if (iu < 8) oo0[d] = MFMA16(vf[i4][d], pf0[iu < 8 ? iu : 0], oo0[d]);
                    if (iu < NR && i1 >= 0 && i1 < 8) oo1[d] = MFMA16(vf[i4][d], pf1[(i1 >= 0 && i1 < 8) ? i1 : 0], oo1[d]);
                }
            }
        }
#pragma unroll
        for (int u = 0; u < 2; ++u) {
            const float inv = 1.f / (u == 0 ? l0 : l1);
            float ss = 0.f;
#pragma unroll
            for (int d = 0; d < 4; ++d) {
                const f32x4 v = (u == 0 ? oo0[d] : oo1[d]) * inv;
                ss += (v[0] * v[0] + v[1] * v[1]) + (v[2] * v[2] + v[3] * v[3]);
                u32x2 w; w.x = cvtpk(v[0], v[1]); w.y = cvtpk(v[2], v[3]);
                *(u32x2*)(mp0 + (size_t)(64 * u + 16 * a) * DM + 16 * d) = w;
            }
            ss += __shfl_xor(ss, 16); ss += __shfl_xor(ss, 32);
            if (g == 0) (u == 0 ? ssq0 : ssq1)[h * 64 + 16 * a + ql] = ss;
        }
    }
}
DI void rescale_b(int b, int blk, int h, int lane, const LAS float* ssqbuf, const float* __restrict__ gain, bf16_t* __restrict__ mix) {
    const int ql = lane & 15, g = lane >> 4;
    const size_t tokb = (size_t)b * SEQ; const int t0 = 64 * blk;
    bf16_t* mp0 = mix + (tokb + t0 + ql) * DM + h * 64 + 4 * g;
#pragma unroll
    for (int a = 0; a < 4; ++a) {
        float tot = 0.f;
#pragma unroll
        for (int h2 = 0; h2 < 8; ++h2) tot += ssqbuf[h2 * 64 + 16 * a + ql];
        const float rsn = rsqrtf(tot * (1.f / 512.f) + EPS);
#pragma unroll
        for (int d = 0; d < 4; ++d) {
            const f32x4 gv = *(const f32x4*)(gain + h * 64 + 16 * d + 4 * g);
            u32x2* p = (u32x2*)(mp0 + (size_t)(16 * a) * DM + 16 * d);
            const u32x2 r = *p;
            u32x2 w; w.x = cvtpk(__uint_as_float(r.x << 16) * rsn * gv[0], __uint_as_float(r.x & 0xffff0000u) * rsn * gv[1]);
            w.y = cvtpk(__uint_as_float(r.y << 16) * rsn * gv[2], __uint_as_float(r.y & 0xffff0000u) * rsn * gv[3]);
            *p = w;
        }
    }
}

DI void attn_table(const Ptrs& P, LAS unsigned char* lds, int tid) {
    LAS float* rpbL = (LAS float*)lds;
    for (int i = tid; i < RPB_FLOATS; i += NTHREADS) rpbL[i] = 0.f;
    __syncthreads();
    for (int i = tid; i < 8 * 15 * 31; i += NTHREADS) { const int hd = i / 465, rem = i % 465, ro = rem / 31, co = rem % 31; rpbL[RPB_PAD + hd * 480 + ro * 32 + co] = P.rpb[i] * LOG2E; }
    __syncthreads();
}
DI void phase_attn(const Ptrs& P, LAS unsigned char* lds, int vcu, int G, int wave, int lane, int tid, bool table_ready) {
    LAS float* rpbL = (LAS float*)lds;
    LAS float* ssqA = (LAS float*)(lds + 32768);
    LAS float* ssqB = (LAS float*)(lds + 32768 + 4096);
    if (!table_ready) attn_table(P, lds, tid);
    const bf16_t* QA = (const bf16_t*)(P.ws + WS_QA); const bf16_t* KA = (const bf16_t*)(P.ws + WS_KA); const bf16_t* VTA = (const bf16_t*)(P.ws + WS_VTA);
    const bf16_t* QB = (const bf16_t*)(P.ws + WS_QB); const bf16_t* KB = (const bf16_t*)(P.ws + WS_KB); const bf16_t* VTB = (const bf16_t*)(P.ws + WS_VTB);
    bf16_t* MIX = (bf16_t*)(P.ws + WS_MIX);
    constexpr int NUNITS = NBATCH * (SEQ / 64);
    const int per = (NUNITS + G - 1) / G;
    const float sinkv = P.sink[wave] * LOG2E;
    if (per == 2) {
        const int unit0 = vcu * 2;
        if (unit0 < NUNITS) {
            const int b = unit0 >> 7, blk0 = unit0 & 127;
#pragma unroll 1
            for (int u = 0; u < 2; ++u) { int ln = lane; asm volatile("" : "+v"(ln)); attend<0>(QA, KA, VTA, b, blk0 + u, wave, ln, sinkv, rpbL, ssqA, P.norm_a, MIX); }
            LAS float* sB1 = ssqB + 512;
            int ln2 = lane; asm volatile("" : "+v"(ln2));
            const int rs0 = min(max(blk0 - 4, 0), 120), rs1 = min(max(blk0 - 3, 0), 120);
            if (rs1 != rs0) attend_b_dual<1>(QB, KB, VTB, b, blk0, wave, ln2, rpbL, ssqB, sB1, MIX + 512);
            else attend_b_dual<0>(QB, KB, VTB, b, blk0, wave, ln2, rpbL, ssqB, sB1, MIX + 512);
            __syncthreads();
            rescale_b(b, blk0, wave, lane, ssqB, P.norm_b, MIX + 512);
            rescale_b(b, blk0 + 1, wave, lane, sB1, P.norm_b, MIX + 512);
        }
    } else
    for (int uu = 0; uu < per; ++uu) {
        const int unit = vcu * per + uu; if (unit >= NUNITS) break;
        const int b = unit >> 7, blk = unit & 127;
        int ln = lane; asm volatile("" : "+v"(ln));
        attend<0>(QA, KA, VTA, b, blk, wave, ln, sinkv, rpbL, ssqA, P.norm_a, MIX);
        int ln2 = lane; asm volatile("" : "+v"(ln2));
        attend16<1>(QB, KB, VTB, b, blk, wave, ln2, 0.f, rpbL, ssqB, P.norm_b, MIX + 512);
    }
    __syncthreads();
}

DI void fixup_rows(const Ptrs& P, int rowi0, int nrows, int t, int nthr) {
    const float* gb = (const float*)(P.ws + WS_GB); const float* ub = (const float*)(P.ws + WS_UB); bf16_t* act = (bf16_t*)(P.ws + WS_ACT);
    constexpr int F4 = DFF / 4;
    for (int it = t; it < nrows * F4; it += nthr) {
        const int rowi = rowi0 + it / F4, f = 4 * (it % F4), blk64 = rowi >> 1, side = rowi & 1;
        const f32x4 zero = {0.f, 0.f, 0.f, 0.f};
        f32x4 gp, gc, gn, uv; int row;
        if (side == 0) {
            row = blk64 * 64;
            gp = (blk64 & 127) == 0 ? zero : *(const f32x4*)(gb + ((size_t)((blk64 - 1) * 4 + 3)) * DFF + f);
            gc = *(const f32x4*)(gb + ((size_t)(blk64 * 4 + 0)) * DFF + f);
            gn = *(const f32x4*)(gb + ((size_t)(blk64 * 4 + 1)) * DFF + f);
            uv = *(const f32x4*)(ub + ((size_t)(blk64 * 2 + 0)) * DFF + f);
        } else {
            row = blk64 * 64 + 63;
            gp = *(const f32x4*)(gb + ((size_t)(blk64 * 4 + 2)) * DFF + f);
            gc = *(const f32x4*)(gb + ((size_t)(blk64 * 4 + 3)) * DFF + f);
            gn = (blk64 & 127) == 127 ? zero : *(const f32x4*)(gb + ((size_t)((blk64 + 1) * 4 + 0)) * DFF + f);
            uv = *(const f32x4*)(ub + ((size_t)(blk64 * 2 + 1)) * DFF + f);
        }
        const f32x4 w0 = *(const f32x4*)(P.conv_w + f), w1 = *(const f32x4*)(P.conv_w + DFF + f), w2 = *(const f32x4*)(P.conv_w + 2 * DFF + f), bb = *(const f32x4*)(P.conv_b + f);
        const f32x4 cv = w0 * gp + w1 * gc + w2 * gn + bb;
        f32x4 a;
#pragma unroll
        for (int j = 0; j < 4; ++j) a[j] = cv[j] * __builtin_amdgcn_rcpf(1.f + fexp2(-LOG2E * cv[j])) * uv[j];
        u32x2 w; w.x = cvtpk(a[0], a[1]); w.y = cvtpk(a[2], a[3]);
        *(u32x2*)(act + (size_t)row * DFF + f) = w;
    }
}

DI void phase_final(const Ptrs& P, int vcu, int G, int wave, int lane) {
    const int gw = vcu * NWAVES + wave, NGW = G * NWAVES;
    f32x4 gm[4];
#pragma unroll
    for (int j = 0; j < 4; ++j) gm[j] = ((const f32x4*)P.norm_final)[lane + 64 * j];
    for (int m = gw; m < MROWS; m += NGW) {
        f32x4* xr = (f32x4*)(P.out + (size_t)m * DM) + lane;
        f32x4 v[4]; float s = 0.f;
#pragma unroll
        for (int j = 0; j < 4; ++j) { v[j] = xr[64 * j]; s += (v[j].x * v[j].x + v[j].y * v[j].y) + (v[j].z * v[j].z + v[j].w * v[j].w); }
        const float rs = rsqrtf(wave_sum(s) * (1.f / DM) + EPS);
#pragma unroll
        for (int j = 0; j < 4; ++j) xr[64 * j] = v[j] * rs * gm[j];
    }
}

struct Args { const float* in[15]; float* out; unsigned char* ws; int ph_lo, ph_hi; };
static_assert(sizeof(Args) == 15 * 8 + 8 + 8 + 8, "Args has no padding");

__global__ void __launch_bounds__(NTHREADS, 2) hybrid_fwd(Args a) {
    extern __shared__ __attribute__((aligned(16))) unsigned char lds_raw[];
    LAS unsigned char* lds = (LAS unsigned char*)lds_raw;
    const int tid = threadIdx.x, lane = tid & 63, wave = __builtin_amdgcn_readfirstlane(tid >> 6);
    const int G = gridDim.x, bx = blockIdx.x;
    const int vcu = (G % 8 == 0) ? (bx % 8) * (G / 8) + bx / 8 : bx;
    Ptrs P;
    P.x = a.in[0]; P.norm_mix = a.in[1]; P.w_in = a.in[2]; P.sink = a.in[3]; P.rpb = a.in[4]; P.norm_a = a.in[5]; P.norm_b = a.in[6]; P.w_out = a.in[7];
    P.norm_ffn = a.in[8]; P.w_gate = a.in[9]; P.w_up = a.in[10]; P.conv_w = a.in[11]; P.conv_b = a.in[12]; P.w_down = a.in[13]; P.norm_final = a.in[14];
    P.out = a.out; P.ws = a.ws;
    const int lo = a.ph_lo, hi = a.ph_hi;
#define IN(k) (lo <= (k) && (k) < hi)
#ifndef PROBE_REPEAT
#define PROBE_REPEAT -1
#endif
    unsigned char* ws = a.ws;
#if MK_N_LAUNCHES == 1
    volatile LAS unsigned* st = (volatile LAS unsigned*)(lds + 131072);
    unsigned* barw = (unsigned*)(ws + WS_BAR);
    if (tid < 2) st[tid] = 0u;
    __syncthreads();
    XcdBarrier xb = xcd_barrier_post(barw, st);
    unsigned* qflags = (unsigned*)(ws + WS_BAR + 16384 + 32768);
    if (tid == 0) __hip_atomic_store(&qflags[64 * vcu + 1], xb_xcc_id() + 1u, __ATOMIC_RELAXED, __HIP_MEMORY_SCOPE_AGENT);
    const bool quads = (G == 256);
#define QSYNC(k, seq, nb) do { if (IN(k) && IN((k) + 1)) { if (quads) quad_sync(qflags, vcu, G / 4, (seq), (nb), tid); else xcd_barrier(xb); } } while (0)
#define SEAM(k) do { if (IN(k) && IN((k) + 1)) { xcd_barrier(xb); } } while (0)
#else
#define SEAM(k) do { } while (0)
#define QSYNC(k, seq, nb) do { } while (0)
    const bool quads = (G == 256);
#endif
    if (IN(0)) {
#if MK_N_LAUNCHES == 1
        if (quads) {
            unsigned* wcnt = (unsigned*)(ws + WS_BAR + 114688 + 128);
            phase0_local(P, lds, vcu, G, wave, lane, tid, wcnt);
            if (IN(1)) {
                if (tid == 0) { unsigned sp = 0; while (xb_ld(wcnt) < (unsigned)G) { __builtin_amdgcn_s_sleep(2); if (++sp > (1u << 22)) break; } }
                quad_sync(qflags, vcu, G / 4, 1u, 0, tid);
            }
        } else
#endif
        { phase0(P, lds, vcu, G, wave, lane, tid); __syncthreads(); SEAM(0); }
    }
    if (IN(1)) {
        pg8::Gemm g{(const bf16_t*)(ws + WS_XN), (const bf16_t*)(ws + WS_WIN), MROWS, DIN, DM}; pg8::StaticOrder S; S.init(MROWS, DIN, G, bx);
        EpiProj E{(bf16_t*)(ws + WS_QA), (bf16_t*)(ws + WS_KA), (bf16_t*)(ws + WS_VTA), (bf16_t*)(ws + WS_QB), (bf16_t*)(ws + WS_KB), (bf16_t*)(ws + WS_VTB), (const float*)(ws + WS_ROPE)};
        if (quads) {
            QuadOrder Q{vcu >> 2, vcu & 3, DIN / 256};
            pg8::gemm_phase<EpiProj, QuadOrder, true, true>(lds, g, Q, E);
            if ((vcu & 3) >= 2) ffn_weights(P, lds, (vcu >> 2) * 2 + (vcu & 1), G / 2, wave, lane);
        } else {
            pg8::gemm_phase<EpiProj, pg8::StaticOrder, true, true>(lds, g, S, E);
            { constexpr int NU = (MROWS / 256) * (DIN / 256); const int rem = NU % G;
              if (rem == 0) ffn_weights(P, lds, bx, G, wave, lane); else if (bx >= rem) ffn_weights(P, lds, bx - rem, G - rem, wave, lane); }
        }
        if (IN(2)) { __syncthreads(); attn_table(P, lds, tid); }
        QSYNC(1, 2u, ((vcu & 3) < 2 ? 1 : 2));
    }
    if (IN(2)) { phase_attn(P, lds, vcu, G, wave, lane, tid, IN(1)); QSYNC(2, 3u, 0); }
    if (IN(3)) {
        pg8::Gemm g{(const bf16_t*)(ws + WS_MIX), (const bf16_t*)(ws + WS_WOUT), MROWS, DM, DM}; pg8::StaticOrder S; S.init(MROWS, DM, G, bx);
        EpiOut E{P.x, (bf16_t*)(ws + WS_H1B), (float*)(ws + WS_SSQ1)};
        if (quads) { QuadOrder Q{vcu >> 2, vcu & 3, 4}; pg8::gemm_phase<EpiOut, QuadOrder, true, true>(lds, g, Q, E); }
        else pg8::gemm_phase<EpiOut, pg8::StaticOrder, true, true>(lds, g, S, E);
#if MK_N_LAUNCHES == 1
        if (quads && IN(4)) { if (tid == 0) { unsigned sp = 0; while (xb_ld((unsigned*)(ws + WS_BAR + 114688)) < (unsigned)(G / 2)) { __builtin_amdgcn_s_sleep(2); if (++sp > (1u << 22)) break; } } }
#endif
        QSYNC(3, 4u, 0);
    }
    if (IN(4)) {
        pg8::Gemm g{(const bf16_t*)(ws + WS_H1B), (const bf16_t*)(ws + WS_WGU), MROWS, NGU, DM}; pg8::StaticOrder S; S.init(MROWS, NGU, G, bx);
        LAS float* rsl = (LAS float*)(lds + RS_OFF);
        QuadOrder Q{vcu >> 2, vcu & 3, NGU / 256};
        { const float* ssq1 = (const float*)(ws + WS_SSQ1); pg8::Unit u0;
          for (int i = 0; i < RS_MAXU && (quads ? Q.next(i, u0) : S.next(i, u0)); ++i) if (tid < 256) {
              const f32x4* pz = (const f32x4*)(ssq1 + (size_t)(u0.pm * 256 + tid) * 16);
              const f32x4 p0 = pz[0], p1 = pz[1], p2 = pz[2], p3 = pz[3];
              const float t = (((p0.x + p0.y) + (p0.z + p0.w)) + ((p1.x + p1.y) + (p1.z + p1.w))) + (((p2.x + p2.y) + (p2.z + p2.w)) + ((p3.x + p3.y) + (p3.z + p3.w)));
              rsl[i * 256 + tid] = rsqrtf(t * (1.f / DM) + EPS); }
          __syncthreads(); }
        EpiGU E{rsl, P.conv_w, P.conv_b, (bf16_t*)(ws + WS_ACT), (float*)(ws + WS_GB), (float*)(ws + WS_UB)};
        if (quads) pg8::gemm_phase<EpiGU, QuadOrder, true, true>(lds, g, Q, E);
        else { OrdOrder SO{S}; pg8::gemm_phase<EpiGU, OrdOrder, true, true>(lds, g, SO, E); }
        QSYNC(4, 5u, ((vcu & 3) == 0 ? 1 : (vcu & 3) == 3 ? 2 : 0));
    }
    if (IN(5)) {
        QuadOrder Q{vcu >> 2, vcu & 3, 4};
        if (quads && MK_N_LAUNCHES == 1) {
            fixup_rows(P, 16 * (vcu >> 2) + 4 * (vcu & 3), 4, tid, NTHREADS);
#if MK_N_LAUNCHES == 1
            quad_sync(qflags, vcu, G / 4, 6u, 0, tid);
#endif
        } else {
          pg8::StaticOrder S0; S0.init(MROWS, DM, G, bx); pg8::Unit u0; int last = -1;
          for (int i = 0; S0.next(i, u0); ++i) { if (u0.pm != last) fixup_rows(P, 8 * u0.pm, 8, tid, NTHREADS); last = u0.pm; }
          asm volatile("s_waitcnt vmcnt(0)" ::: "memory"); __syncthreads(); }
        pg8::Gemm g{(const bf16_t*)(ws + WS_ACT), (const bf16_t*)(ws + WS_WDN), MROWS, DM, DFF}; pg8::StaticOrder S; S.init(MROWS, DM, G, bx);
        EpiDownNorm E{(const bf16_t*)(ws + WS_H1B), P.out, P.norm_final, (float*)(ws + WS_SSQ2), (unsigned*)(ws + WS_BAR + 16384)};
        if (quads) pg8::gemm_phase<EpiDownNorm, QuadOrder, true, true>(lds, g, Q, E);
        else pg8::gemm_phase<EpiDownNorm, pg8::StaticOrder, true, true>(lds, g, S, E);
    }
#undef IN
#undef SEAM
#undef QSYNC
}

extern "C" void kernel_launch(void* const* d_in, const int* in_sizes, int n_in, void* d_out, int out_size, void* d_ws, size_t ws_size, hipStream_t stream) {
    static int grid = 0;
    if (grid == 0) {
        if (n_in != 15 || in_sizes[0] != MROWS * DM || out_size != MROWS * DM || ws_size < WS_END) {
            fprintf(stderr, "kernel_launch: unexpected shapes (n_in %d, in0 %d, out %d, ws %zu); nothing launched\n", n_in, n_in > 0 ? in_sizes[0] : -1, out_size, ws_size); grid = -1; return; }
        int dev = 0, cus = 0, per_cu = 0;
        if (hipGetDevice(&dev) != hipSuccess || hipDeviceGetAttribute(&cus, hipDeviceAttributeMultiprocessorCount, dev) != hipSuccess) { fprintf(stderr, "kernel_launch: device query failed\n"); grid = -1; return; }
        if (hipFuncSetAttribute((const void*)hybrid_fwd, hipFuncAttributeMaxDynamicSharedMemorySize, LDS_BYTES) != hipSuccess) { fprintf(stderr, "kernel_launch: hipFuncSetAttribute failed\n"); grid = -1; return; }
        if (hipOccupancyMaxActiveBlocksPerMultiprocessor(&per_cu, (const void*)hybrid_fwd, NTHREADS, LDS_BYTES) != hipSuccess || per_cu < 1) {
            fprintf(stderr, "kernel_launch: occupancy query reports %d workgroups per CU; nothing launched\n", per_cu); (void)hipGetLastError(); grid = -1; return; }
        grid = cus;
    }
    if (grid < 0) return;
    Args a{};
    for (int i = 0; i < 15; ++i) a.in[i] = (const float*)d_in[i];
    a.out = (float*)d_out; a.ws = (unsigned char*)d_ws;
    if (hipMemsetAsync((char*)d_ws + WS_BAR, 0, 114688 + 256, stream) != hipSuccess) { fprintf(stderr, "kernel_launch: memset of the barrier words failed\n"); return; }
#if MK_N_LAUNCHES == 1
    a.ph_lo = 0; a.ph_hi = NPHASE;
    hipLaunchKernelGGL(hybrid_fwd, dim3(grid), dim3(NTHREADS), LDS_BYTES, stream, a);
#else
    for (int p = 0; p < NPHASE; ++p) {
        a.ph_lo = p; a.ph_hi = p + 1;
        hipLaunchKernelGGL(hybrid_fwd, dim3(grid), dim3(NTHREADS), LDS_BYTES, stream, a);
        if (p == PROBE_REPEAT) hipLaunchKernelGGL(hybrid_fwd, dim3(grid), dim3(NTHREADS), LDS_BYTES, stream, a);
    }
#endif
}
```

```cpp
#include <hip/hip_runtime.h>
#include <hip/hip_cooperative_groups.h>
#include <cstdio>
#include <cstdint>
#include <cmath>
namespace cg = cooperative_groups;
namespace pg8 {
#define PG8_LAS __attribute__((address_space(3)))
typedef unsigned short bf16_t;
typedef short bf16x8 __attribute__((ext_vector_type(8)));
typedef float f32x4 __attribute__((ext_vector_type(4)));
typedef unsigned u32x4 __attribute__((ext_vector_type(4)));
constexpr int BM = 256, BK = 64, HALF = 128, HTB = HALF * BK * 2  , STAGE_BYTES = 8 * HTB, NXCD = 8, WGM = 8;

__host__ __device__ __forceinline__ int lds_byte(int r, int c) { const int st = (r >> 4) * 2 + (c >> 5), rr = r & 15, cc = c & 31, ob = rr * 64 + cc * 2; return st * 1024 + (ob ^ (((ob >> 9) & 1) << 5)); }
__host__ __device__ __forceinline__ void stage_rc(int b, int& R, int& C) { const int st = b / 1024, sb = b % 1024, swz = sb ^ (((sb >> 9) & 1) << 5); R = (st >> 1) * 16 + swz / 64; C = (st & 1) * 32 + (swz % 64) / 2; }
__host__ __device__ __forceinline__ int perm32(int rho) { const int n = rho >> 4, i = rho & 15; return 8 * (i >> 2) + 4 * n + (i & 3); }

struct Unit { int pm, pn, ord; };
struct Gemm { const bf16_t* A; const bf16_t* Bt; int M, N, K; };

struct StaticOrder {
    int nM, nN, nwg, G, c;
    __host__ __device__ __forceinline__ void init(int M, int N, int G_, int c_) { nM = M / BM; nN = N / BM; nwg = nM * nN; G = G_; c = c_; }
    __host__ __device__ __forceinline__ bool next(int i, Unit& u) const {
        const long L = (long)i * G + c; if (L >= nwg) return false;
        int wgid = (int)L; { const int q = nwg / NXCD, r = nwg % NXCD, xcd = wgid % NXCD, off = wgid / NXCD; wgid = (xcd < r ? xcd * (q + 1) : r * (q + 1) + (xcd - r) * q) + off; }
        const int nig = WGM * nN, gid = wgid / nig, fm = gid * WGM, gsz = (nM - fm) < WGM ? (nM - fm) : WGM;
        u.pm = fm + ((wgid % nig) % gsz); u.pn = (wgid % nig) / gsz; return true;
    }
    __device__ __forceinline__ void a_ready(const Unit&) const {}
    __device__ __forceinline__ void done(const Unit&) const {}
};
__device__ __forceinline__ unsigned cvt_pk_bf16(float lo, float hi) { unsigned r; asm volatile("v_cvt_pk_bf16_f32 %0, %1, %2" : "=v"(r) : "v"(lo), "v"(hi)); return r; }
typedef float f32x2 __attribute__((ext_vector_type(2)));
template <class Epi, class Sched, bool ALIGN_EPI = false, bool SP2 = false>
__device__ __forceinline__ void gemm_phase(PG8_LAS unsigned char* lds, const Gemm g, const Sched& S, const Epi& E) {
    const int tid = threadIdx.x, wid = __builtin_amdgcn_readfirstlane(tid >> 6), lane = tid & 63, wr = wid >> 2, wc = wid & 3, fr = lane & 15, fq = lane >> 4;
    const int K = g.K, nt = K / BK;
    unsigned voffA[2], voffB[2];
#pragma unroll
    for (int i = 0; i < 2; ++i) { int R, C; stage_rc(tid * 16 + i * 8192, R, C); const int Rb = Epi::PERM ? ((R & ~31) + perm32(R & 31)) : R;
        voffA[i] = (unsigned)(R * K + C) * 2u; voffB[i] = (unsigned)(Rb * K + C) * 2u; }
    const size_t kstep = (size_t)(BK * 2);
    const size_t hstep = (size_t)HALF * K * 2;
    const size_t tstep = 2 * hstep;
    const unsigned ldsw = (unsigned)wid * 1024u;
    const int aoff = lds_byte(wr * 64 + fr, fq * 8), boff = lds_byte(wc * 32 + fr, fq * 8);
#define PG8_SA(b, h) (((b) * 2 + (h)) * HTB)
#define PG8_SB(b, h) ((4 + (b) * 2 + (h)) * HTB)
#define PG8_STAGE(bufoff, gbase, voff) do { _Pragma("unroll") for (int _i = 0; _i < 2; ++_i) \
        __builtin_amdgcn_global_load_lds((const unsigned*)((const char*)(gbase) + (voff)[_i]), (PG8_LAS unsigned*)(lds + (bufoff) + ldsw + _i * 8192), 16, 0, 0); } while (0)
#define PG8_LDA(dst, b, h) do { _Pragma("unroll") for (int m = 0; m < 4; ++m) _Pragma("unroll") for (int k = 0; k < 2; ++k) dst[m][k] = *(const PG8_LAS bf16x8*)(lds + PG8_SA(b, h) + aoff + m * 2048 + k * 1024); } while (0)
#define PG8_LDB(dst, b, h) do { _Pragma("unroll") for (int n = 0; n < 2; ++n) _Pragma("unroll") for (int k = 0; k < 2; ++k) dst[n][k] = *(const PG8_LAS bf16x8*)(lds + PG8_SB(b, h) + boff + n * 2048 + k * 1024); } while (0)
#define PG8_MMA(ai, bj, At, Bt) do { __builtin_amdgcn_s_setprio(1); _Pragma("unroll") for (int m = 0; m < 4; ++m) _Pragma("unroll") for (int n = 0; n < 2; ++n) _Pragma("unroll") for (int k = 0; k < 2; ++k) \
        acc[ai][bj][m][n] = __builtin_amdgcn_mfma_f32_16x16x32_bf16(Bt[n][k], At[m][k], acc[ai][bj][m][n], 0, 0, 0); __builtin_amdgcn_s_setprio(0); } while (0)
#define PG8_WAIT_V(n) asm volatile("s_waitcnt vmcnt(" #n ")" ::: "memory")
#define PG8_WAIT_L(n) asm volatile("s_waitcnt lgkmcnt(" #n ")" ::: "memory")
#define PG8_BAR __builtin_amdgcn_s_barrier()
#define PG8_SCHED __builtin_amdgcn_sched_barrier(0)
    Unit cur, nxt; int ui = 0;
    if (!S.next(0, cur)) return;
    f32x4 acc[2][2][4][2];
#pragma unroll
    for (int a = 0; a < 2; ++a)
#pragma unroll
        for (int b = 0; b < 2; ++b)
#pragma unroll
            for (int m = 0; m < 4; ++m)
#pragma unroll
                for (int n = 0; n < 2; ++n) acc[a][b][m][n] = (f32x4){0.f, 0.f, 0.f, 0.f};
    bf16x8 At[4][2], B0[2][2], B1[2][2];
    const char* cA = (const char*)g.A + (size_t)cur.pm * tstep; const char* cB = (const char*)g.Bt + (size_t)cur.pn * tstep;
    S.a_ready(cur);
    if constexpr (SP2) {
        PG8_STAGE(PG8_SB(0, 0), cB, voffB); PG8_STAGE(PG8_SB(0, 1), cB + hstep, voffB); PG8_STAGE(PG8_SA(0, 0), cA, voffA); PG8_STAGE(PG8_SA(0, 1), cA + hstep, voffA);
        if (wr == 1) PG8_BAR;
        PG8_WAIT_V(2); PG8_BAR;
        PG8_STAGE(PG8_SB(1, 0), cB + kstep, voffB); PG8_STAGE(PG8_SA(1, 0), cA + kstep, voffA); PG8_STAGE(PG8_SB(1, 1), cB + hstep + kstep, voffB);
        PG8_WAIT_V(6); PG8_BAR;
    } else {
        PG8_STAGE(PG8_SB(0, 0), cB, voffB); PG8_STAGE(PG8_SA(0, 0), cA, voffA); PG8_STAGE(PG8_SB(0, 1), cB + hstep, voffB); PG8_STAGE(PG8_SA(0, 1), cA + hstep, voffA);
        if (wr == 1) PG8_BAR;
        PG8_WAIT_V(4); PG8_BAR;
        PG8_STAGE(PG8_SB(1, 0), cB + kstep, voffB); PG8_STAGE(PG8_SA(1, 0), cA + kstep, voffA); PG8_STAGE(PG8_SB(1, 1), cB + hstep + kstep, voffB);
        PG8_WAIT_V(6); PG8_BAR;
    }
    for (;;) {
        const bool has_next = S.next(ui + 1, nxt);
        const char* nA = has_next ? (const char*)g.A + (size_t)nxt.pm * tstep : cA; const char* nB = has_next ? (const char*)g.Bt + (size_t)nxt.pn * tstep : cB;
        for (int t = 0; t < nt; t += 2) {
            const bool last = (t == nt - 2);
            const char* a1 = cA + (size_t)(t + 1) * kstep;
            const char* a2 = last ? nA : cA + (size_t)(t + 2) * kstep; const char* b2 = last ? nB : cB + (size_t)(t + 2) * kstep;
            const char* a3 = a2 + kstep; const char* b3 = b2 + kstep;
            if (last && has_next) S.a_ready(nxt);
            if constexpr (SP2) {
            PG8_LDB(B0, 0, 0); PG8_LDB(B1, 0, 1); PG8_SCHED; PG8_LDA(At, 0, 0); PG8_STAGE(PG8_SA(1, 1), a1 + hstep, voffA);
            PG8_WAIT_V(8); PG8_WAIT_L(0); PG8_BAR; PG8_MMA(0, 0, At, B0); PG8_MMA(0, 1, At, B1); PG8_BAR; PG8_SCHED;
            PG8_LDA(At, 0, 1); PG8_STAGE(PG8_SB(0, 0), b2, voffB); PG8_STAGE(PG8_SB(0, 1), b2 + hstep, voffB); PG8_STAGE(PG8_SA(0, 0), a2, voffA);
            PG8_WAIT_V(8); PG8_WAIT_L(0); PG8_BAR; PG8_MMA(1, 0, At, B0); PG8_MMA(1, 1, At, B1); PG8_BAR; PG8_SCHED;
            PG8_LDB(B0, 1, 0); PG8_LDB(B1, 1, 1); PG8_SCHED; PG8_LDA(At, 1, 0); PG8_STAGE(PG8_SA(0, 1), a2 + hstep, voffA);
            PG8_WAIT_V(8); PG8_WAIT_L(0); PG8_BAR; PG8_MMA(0, 0, At, B0); PG8_MMA(0, 1, At, B1); PG8_BAR; PG8_SCHED;
            PG8_LDA(At, 1, 1); PG8_STAGE(PG8_SB(1, 0), b3, voffB); PG8_STAGE(PG8_SB(1, 1), b3 + hstep, voffB); PG8_STAGE(PG8_SA(1, 0), a3, voffA);
            PG8_WAIT_V(8); PG8_WAIT_L(0); PG8_BAR; PG8_MMA(1, 0, At, B0); PG8_MMA(1, 1, At, B1); PG8_BAR; PG8_SCHED;
            } else {
            PG8_LDB(B0, 0, 0); PG8_SCHED; PG8_LDA(At, 0, 0); PG8_STAGE(PG8_SA(1, 1), a1 + hstep, voffA);
            PG8_WAIT_L(8); PG8_BAR; PG8_WAIT_L(0); PG8_MMA(0, 0, At, B0); PG8_BAR; PG8_SCHED;
            PG8_LDB(B1, 0, 1); PG8_STAGE(PG8_SB(0, 0), b2, voffB);
            PG8_BAR; PG8_WAIT_L(0); PG8_MMA(0, 1, At, B1); PG8_BAR;
            PG8_LDA(At, 0, 1); PG8_STAGE(PG8_SA(0, 0), a2, voffA);
            PG8_BAR; PG8_WAIT_L(0); PG8_MMA(1, 0, At, B0); PG8_BAR; PG8_SCHED;
            PG8_STAGE(PG8_SB(0, 1), b2 + hstep, voffB);
            PG8_WAIT_V(6); PG8_BAR; PG8_MMA(1, 1, At, B1); PG8_BAR;
            PG8_LDB(B0, 1, 0); PG8_SCHED; PG8_LDA(At, 1, 0); PG8_STAGE(PG8_SA(0, 1), a2 + hstep, voffA);
            PG8_WAIT_L(8); PG8_BAR; PG8_WAIT_L(0); PG8_MMA(0, 0, At, B0); PG8_BAR; PG8_SCHED;
            PG8_LDB(B1, 1, 1); PG8_STAGE(PG8_SB(1, 0), b3, voffB);
            PG8_BAR; PG8_WAIT_L(0); PG8_MMA(0, 1, At, B1); PG8_BAR;
            PG8_LDA(At, 1, 1); PG8_STAGE(PG8_SA(1, 0), a3, voffA);
            PG8_BAR; PG8_WAIT_L(0); PG8_MMA(1, 0, At, B0); PG8_BAR; PG8_SCHED;
            PG8_STAGE(PG8_SB(1, 1), b3 + hstep, voffB);
            PG8_WAIT_V(6); PG8_BAR; PG8_MMA(1, 1, At, B1); PG8_BAR;
            }
        }
        if constexpr (ALIGN_EPI) { if (wr == 0) PG8_BAR; }
        if constexpr (!Epi::AFTER_DRAIN) { E(acc, cur, wr, wc, fr, fq); S.done(cur); }
        if (!has_next) break;
#pragma unroll
        for (int a = 0; a < 2; ++a)
#pragma unroll
            for (int b = 0; b < 2; ++b)
#pragma unroll
                for (int m = 0; m < 4; ++m)
#pragma unroll
                    for (int n = 0; n < 2; ++n) acc[a][b][m][n] = (f32x4){0.f, 0.f, 0.f, 0.f};
        cur = nxt; cA = nA; cB = nB; ++ui;
        if constexpr (ALIGN_EPI) { if (wr == 1) PG8_BAR; }
    }
    PG8_WAIT_V(0);
    if constexpr (!ALIGN_EPI) { if (wr == 0) PG8_BAR; }
    PG8_BAR;
    if constexpr (Epi::AFTER_DRAIN) { E.fused(acc, cur, wr, wc, fr, fq, lds, wid, lane); S.done(cur); }
#undef PG8_SA
#undef PG8_SB
#undef PG8_STAGE
#undef PG8_LDA
#undef PG8_LDB
#undef PG8_MMA
#undef PG8_WAIT_V
#undef PG8_WAIT_L
#undef PG8_BAR
#undef PG8_SCHED
}
}

#ifndef MK_N_LAUNCHES
#define MK_N_LAUNCHES 1
#endif
#define DI __device__ __forceinline__
#define LAS __attribute__((address_space(3)))
typedef unsigned short bf16_t;
typedef short bf16x8 __attribute__((ext_vector_type(8)));
typedef float f32x4 __attribute__((ext_vector_type(4)));
typedef float f32x16 __attribute__((ext_vector_type(16)));
typedef unsigned u32x4 __attribute__((ext_vector_type(4)));
typedef unsigned u32x2 __attribute__((ext_vector_type(2)));
typedef float f32x2_t __attribute__((ext_vector_type(2)));
typedef __bf16 bf16x2_t __attribute__((ext_vector_type(2)));

constexpr int DM = 1024, NBATCH = 4, SEQ = 8192, MROWS = NBATCH * SEQ, DIN = 2304, DFF = 2816, NGU = 2 * DFF;
constexpr float EPS = 1e-6f, LOG2E = 1.4426950408889634f, QSCALE = 0.125f * LOG2E;
constexpr int NPHASE = 6;
constexpr int NTHREADS = 512, NWAVES = 8;
constexpr int LDS_BYTES = 147456;

constexpr size_t MiB = 1u << 20;
constexpr size_t WS_WIN = 0, WS_WOUT = 5 * MiB, WS_WGU = 7 * MiB, WS_WDN = 18 * MiB, WS_ROPE = 24 * MiB, WS_SSQ1 = 25 * MiB, WS_SSQ2 = 27 * MiB;
constexpr size_t WS_GB = 29 * MiB, WS_UB = 51 * MiB;
constexpr size_t WS_XN = 64 * MiB, WS_MIX = 64 * MiB;
constexpr size_t WS_H1B = 128 * MiB;
constexpr size_t WS_QA = 192 * MiB, WS_KA = 224 * MiB, WS_VTA = 232 * MiB, WS_QB = 240 * MiB, WS_KB = 272 * MiB, WS_VTB = 304 * MiB;
constexpr size_t WS_ACT = 336 * MiB;
constexpr size_t WS_END = 512 * MiB;
static_assert(WS_ACT + (size_t)MROWS * DFF * 2 <= WS_END, "workspace map");
constexpr size_t WS_BAR = 24 * MiB + 768 * 1024;

DI unsigned cvtpk(float lo, float hi) { f32x2_t v = {lo, hi}; bf16x2_t b = __builtin_convertvector(v, bf16x2_t); return __builtin_bit_cast(unsigned, b); }
DI float wave_sum(float v) {
#pragma unroll
    for (int o = 1; o < 64; o <<= 1) v += __shfl_xor(v, o);
    return v;
}
DI float fexp2(float x) { return __builtin_amdgcn_exp2f(x); }
typedef __amdgpu_buffer_rsrc_t rsrc_t;
DI rsrc_t mk_rsrc(const void* base) { return __builtin_amdgcn_make_buffer_rsrc((void*)base, 0, 0x7ffffff0, 0x00020000); }
DI void st16_wt(rsrc_t r, unsigned byte_off, u32x4 v) { __builtin_amdgcn_raw_buffer_store_b128(v, r, (int)byte_off, 0, 16); }
template <int CTRL> DI float dpp_ror(float v) { return __builtin_bit_cast(float, __builtin_amdgcn_update_dpp(0, __builtin_bit_cast(int, v), CTRL, 0xf, 0xf, false)); }

#define XB_TMO      128
#define XB_XCNT(j)  (256  + 64 * (j))
#define XB_XSUB(j)  (1280 + 64 * (j))
#define XB_XGEN(j)  (2304 + 64 * (j))
#define XB_TOP      3328
#define XB_TOPGEN   3392
#define XCD_BAR_WORDS 3456
#define XB_SPIN_CAP (1u << 18)

__device__ __forceinline__ unsigned xb_ld(unsigned* p)              { return __hip_atomic_load(p, __ATOMIC_RELAXED, __HIP_MEMORY_SCOPE_AGENT); }
__device__ __forceinline__ unsigned xb_add(unsigned* p, unsigned v) { return __hip_atomic_fetch_add(p, v, __ATOMIC_RELAXED, __HIP_MEMORY_SCOPE_AGENT); }
__device__ __forceinline__ unsigned xb_xcc_id() { return (unsigned)__builtin_amdgcn_s_getreg((3 << 11) | 20) & 0xFu; }
#define XB_SPIN(cond, bar) do { unsigned _sp = 0; while (cond) { __builtin_amdgcn_s_sleep(1); \
    if ((++_sp & 255u) == 0u) { if (xb_ld(&(bar)[XB_TMO])) break; if (_sp > XB_SPIN_CAP) { atomicAdd(&(bar)[XB_TMO], 1u); break; } } } } while (0)

struct XcdBarrier {
    unsigned* bar; unsigned x;
    volatile LAS unsigned* st;
};

__device__ __forceinline__ XcdBarrier xcd_barrier_post(unsigned* bar, volatile LAS unsigned* st) {
    XcdBarrier b; b.bar = bar; b.x = xb_xcc_id(); b.st = st;
    if (threadIdx.x == 0) (void)xb_add(&bar[XB_XCNT(b.x)], 1u);
    return b;
}
__device__ __forceinline__ void xcd_barrier_complete(unsigned* bar, unsigned x, unsigned& nloc, unsigned& nx) {
    const unsigned G = gridDim.x * gridDim.y * gridDim.z;
    unsigned sum, cnt, mine, sp = 0u;
    for (;;) {
        sum = 0u; cnt = 0u; mine = 0u;
#pragma unroll
        for (unsigned j = 0; j < 16; ++j) { const unsigned c = xb_ld(&bar[XB_XCNT(j)]); sum += c; cnt += (c > 0u) ? 1u : 0u; mine = (j == x) ? c : mine; }
        if (sum == G) break;
        __builtin_amdgcn_s_sleep(1);
        if ((++sp & 255u) == 0u) { if (xb_ld(&bar[XB_TMO])) break; if (sp > XB_SPIN_CAP) { atomicAdd(&bar[XB_TMO], 1u); break; } }
    }
    nloc = mine > 0u ? mine : 1u; nx = cnt > 0u ? cnt : 1u;
}

__device__ __forceinline__ void xcd_barrier(const XcdBarrier& b) {
    asm volatile("s_waitcnt vmcnt(0)" ::: "memory");
    __syncthreads();
    if (threadIdx.x == 0) {
        unsigned* bar = b.bar;
        __builtin_amdgcn_s_waitcnt(0);
        unsigned nloc = b.st[0], nx = b.st[1];
        if (nloc == 0u) { xcd_barrier_complete(bar, b.x, nloc, nx); b.st[0] = nloc; b.st[1] = nx; }
        const unsigned old = xb_add(&bar[XB_XSUB(b.x)], 1u);
        const unsigned gen = old / nloc;
        if (old + 1u == (gen + 1u) * nloc) {
            __builtin_amdgcn_fence(__ATOMIC_RELEASE, "agent");
            asm volatile("s_waitcnt vmcnt(0)" ::: "memory");
            const unsigned og = xb_add(&bar[XB_TOP], 1u);
            const unsigned tg = og / nx;
            if (og + 1u == (tg + 1u) * nx) xb_add(&bar[XB_TOPGEN], 1u);
            else XB_SPIN(xb_ld(&bar[XB_TOPGEN]) == tg, bar);
            __builtin_amdgcn_fence(__ATOMIC_ACQUIRE, "agent");
            xb_add(&bar[XB_XGEN(b.x)], 1u);
            asm volatile("s_waitcnt vmcnt(0)" ::: "memory");
        } else {
            XB_SPIN(xb_ld(&bar[XB_XGEN(b.x)]) == gen, bar);
            __builtin_amdgcn_fence(__ATOMIC_ACQUIRE, "agent");
            asm volatile("s_waitcnt vmcnt(0)" ::: "memory");
        }
    }
    __syncthreads();
}


template <int MODE, bool WT_THROUGH = false>
DI void p0_transpose_item(const float* __restrict__ W, int K, int N, bf16_t* __restrict__ WT, LAS float* scr, int item, int lane, const float* __restrict__ ks) {
    const int nblk = N / 32, kb = item / nblk, nb = item % nblk, k0 = 64 * kb, n0 = 32 * nb;
#pragma unroll 8
    for (int i = 0; i < 32; ++i) { const int kk = 2 * i + (lane >> 5); float v = W[(size_t)(k0 + kk) * N + n0 + (lane & 31)]; if (MODE != 0) v *= ks[k0 + kk]; scr[kk * 33 + (lane & 31)] = v; }
    asm volatile("s_waitcnt lgkmcnt(0)" ::: "memory");
    const int c = lane & 7;
    const int rbase = (MODE == 0) ? n0 : (256 * (n0 >> 7) + (n0 & 127) + (MODE == 2 ? 128 : 0));
#pragma unroll
    for (int j = 0; j < 4; ++j) { const int n = (lane >> 3) + 8 * j; const LAS float* s = scr + (8 * c) * 33 + n;
        u32x4 o; o.x = cvtpk(s[0 * 33], s[1 * 33]); o.y = cvtpk(s[2 * 33], s[3 * 33]); o.z = cvtpk(s[4 * 33], s[5 * 33]); o.w = cvtpk(s[6 * 33], s[7 * 33]);
        if (MODE == 0 && !WT_THROUGH) *(u32x4*)(WT + (size_t)(rbase + n) * K + k0 + 8 * c) = o;
        else st16_wt(mk_rsrc(WT), (unsigned)(((rbase + n) * K + k0 + 8 * c) * 2), o); }
    asm volatile("s_waitcnt lgkmcnt(0)" ::: "memory");
}

struct Ptrs {
    const float *x, *norm_mix, *w_in, *sink, *rpb, *norm_a, *norm_b, *w_out, *norm_ffn, *w_gate, *w_up, *conv_w, *conv_b, *w_down, *norm_final;
    float* out; unsigned char* ws;
};

DI void phase0_local(const Ptrs& P, LAS unsigned char* lds, int vcu, int G, int wave, int lane, int tid, unsigned* wcnt) {
    LAS float* scr = (LAS float*)(lds + wave * 16384);
    const int gw = vcu * NWAVES + wave, NGW = G * NWAVES;
    bf16_t* WIN = (bf16_t*)(P.ws + WS_WIN); bf16_t* WOUT = (bf16_t*)(P.ws + WS_WOUT);
    constexpr int I_IN = (DM / 64) * (DIN / 32), I_OUT = (DM / 64) * (DM / 32);
    for (int it = gw; it < I_IN + I_OUT; it += NGW) {
        int r = it;
        if (r < I_IN) { p0_transpose_item<0, true>(P.w_in, DM, DIN, WIN, scr, r, lane, nullptr); continue; } r -= I_IN;
        p0_transpose_item<0, true>(P.w_out, DM, DM, WOUT, scr, r, lane, nullptr);
    }
    float* rope = (float*)(P.ws + WS_ROPE);
    for (int idx = vcu * NTHREADS + tid; idx < SEQ * 8; idx += G * NTHREADS) {
        const int pos = idx >> 3, i = idx & 7;
        const double inv = i == 0 ? 1.0 : i == 1 ? 0.19392274474868576 : i == 2 ? 0.03760603093086393 : i == 3 ? 0.007292664737217109 : i == 4 ? 0.001414213562373095
                         : i == 5 ? 0.0002742481756762073 : i == 6 ? 5.318295896944988e-05 : 1.031338537721246e-05;
        const double t = (double)pos * inv * 0.15915494309189535;
        const float fr = (float)(t - (double)(long long)t);
        __hip_atomic_store(rope + pos * 16 + i, __builtin_amdgcn_cosf(fr), __ATOMIC_RELAXED, __HIP_MEMORY_SCOPE_AGENT);
        __hip_atomic_store(rope + pos * 16 + 8 + i, __builtin_amdgcn_sinf(fr), __ATOMIC_RELAXED, __HIP_MEMORY_SCOPE_AGENT);
    }
    asm volatile("s_waitcnt vmcnt(0)" ::: "memory"); __syncthreads();
    if (tid == 0) __hip_atomic_fetch_add(wcnt, 1u, __ATOMIC_RELAXED, __HIP_MEMORY_SCOPE_AGENT);
    bf16_t* XN = (bf16_t*)(P.ws + WS_XN);
    f32x4 gm[4];
#pragma unroll
    for (int j = 0; j < 4; ++j) gm[j] = ((const f32x4*)P.norm_mix)[lane + 64 * j];
    for (int k = 0; k < 16; k += 2) {
        const int m0 = vcu * 128 + wave + 8 * k, m1 = m0 + 8;
        const f32x4* xr0 = (const f32x4*)(P.x + (size_t)m0 * DM) + lane; const f32x4* xr1 = (const f32x4*)(P.x + (size_t)m1 * DM) + lane;
        f32x4 v0[4], v1[4]; float s0 = 0.f, s1 = 0.f;
#pragma unroll
        for (int j = 0; j < 4; ++j) { v0[j] = xr0[64 * j]; v1[j] = xr1[64 * j]; }
#pragma unroll
        for (int j = 0; j < 4; ++j) { s0 += (v0[j].x * v0[j].x + v0[j].y * v0[j].y) + (v0[j].z * v0[j].z + v0[j].w * v0[j].w); s1 += (v1[j].x * v1[j].x + v1[j].y * v1[j].y) + (v1[j].z * v1[j].z + v1[j].w * v1[j].w); }
        const float rs0 = rsqrtf(wave_sum(s0) * (1.f / DM) + EPS), rs1 = rsqrtf(wave_sum(s1) * (1.f / DM) + EPS);
        u32x2* o0 = (u32x2*)(XN + (size_t)m0 * DM) + lane; u32x2* o1 = (u32x2*)(XN + (size_t)m1 * DM) + lane;
#pragma unroll
        for (int j = 0; j < 4; ++j) { u32x2 w; w.x = cvtpk(v0[j].x * rs0 * gm[j].x, v0[j].y * rs0 * gm[j].y); w.y = cvtpk(v0[j].z * rs0 * gm[j].z, v0[j].w * rs0 * gm[j].w); o0[64 * j] = w;
            u32x2 w1; w1.x = cvtpk(v1[j].x * rs1 * gm[j].x, v1[j].y * rs1 * gm[j].y); w1.y = cvtpk(v1[j].z * rs1 * gm[j].z, v1[j].w * rs1 * gm[j].w); o1[64 * j] = w1; }
    }
}
DI void phase0(const Ptrs& P, LAS unsigned char* lds, int vcu, int G, int wave, int lane, int tid) {
    LAS float* scr = (LAS float*)(lds + wave * 16384);
    const int gw = vcu * NWAVES + wave, NGW = G * NWAVES;
    bf16_t* WIN = (bf16_t*)(P.ws + WS_WIN); bf16_t* WOUT = (bf16_t*)(P.ws + WS_WOUT); bf16_t* WGU = (bf16_t*)(P.ws + WS_WGU); bf16_t* WDN = (bf16_t*)(P.ws + WS_WDN);
    constexpr int I_IN = (DM / 64) * (DIN / 32), I_OUT = (DM / 64) * (DM / 32), I_G = (DM / 64) * (DFF / 32), I_D = (DFF / 64) * (DM / 32);
    constexpr int NITEMS = I_IN + I_OUT + 2 * I_G + I_D;
    (void)WGU; (void)WDN; (void)NITEMS;
    for (int it = gw; it < I_IN + I_OUT; it += NGW) {
        int r = it;
        if (r < I_IN) { p0_transpose_item<0>(P.w_in, DM, DIN, WIN, scr, r, lane, nullptr); continue; } r -= I_IN;
        p0_transpose_item<0>(P.w_out, DM, DM, WOUT, scr, r, lane, nullptr);
    }
    bf16_t* XN = (bf16_t*)(P.ws + WS_XN);
    f32x4 gm[4];
#pragma unroll
    for (int j = 0; j < 4; ++j) gm[j] = ((const f32x4*)P.norm_mix)[lane + 64 * j];
    for (int m = gw; m < MROWS; m += NGW) {
        const f32x4* xr = (const f32x4*)(P.x + (size_t)m * DM) + lane;
        f32x4 v[4]; float s = 0.f;
#pragma unroll
        for (int j = 0; j < 4; ++j) { v[j] = xr[64 * j]; s += (v[j].x * v[j].x + v[j].y * v[j].y) + (v[j].z * v[j].z + v[j].w * v[j].w); }
        const float rs = rsqrtf(wave_sum(s) * (1.f / DM) + EPS);
        u32x2* o8 = (u32x2*)(XN + (size_t)m * DM) + lane;
#pragma unroll
        for (int j = 0; j < 4; ++j) { u32x2 w; w.x = cvtpk(v[j].x * rs * gm[j].x, v[j].y * rs * gm[j].y); w.y = cvtpk(v[j].z * rs * gm[j].z, v[j].w * rs * gm[j].w); o8[64 * j] = w; }
    }
    float* rope = (float*)(P.ws + WS_ROPE);
    for (int idx = vcu * NTHREADS + tid; idx < SEQ * 8; idx += G * NTHREADS) {
        const int pos = idx >> 3, i = idx & 7;
        const double inv = i == 0 ? 1.0 : i == 1 ? 0.19392274474868576 : i == 2 ? 0.03760603093086393 : i == 3 ? 0.007292664737217109 : i == 4 ? 0.001414213562373095
                         : i == 5 ? 0.0002742481756762073 : i == 6 ? 5.318295896944988e-05 : 1.031338537721246e-05;
        const double t = (double)pos * inv * 0.15915494309189535;
        const float fr = (float)(t - (double)(long long)t);
        rope[pos * 16 + i] = __builtin_amdgcn_cosf(fr);
        rope[pos * 16 + 8 + i] = __builtin_amdgcn_sinf(fr);
    }
}

DI void ffn_weights(const Ptrs& P, LAS unsigned char* lds, int part, int nparts, int wave, int lane) {
    LAS float* scr = (LAS float*)(lds + wave * 16384);
    bf16_t* WGU = (bf16_t*)(P.ws + WS_WGU); bf16_t* WDN = (bf16_t*)(P.ws + WS_WDN);
    constexpr int I_G = (DM / 64) * (DFF / 32), I_D = (DFF / 64) * (DM / 32);
    for (int it = part * NWAVES + wave; it < 2 * I_G + I_D; it += nparts * NWAVES) {
        int r = it;
        if (r < I_G) { p0_transpose_item<1>(P.w_gate, DM, DFF, WGU, scr, r, lane, P.norm_ffn); continue; } r -= I_G;
        if (r < I_G) { p0_transpose_item<2>(P.w_up, DM, DFF, WGU, scr, r, lane, P.norm_ffn); continue; } r -= I_G;
        p0_transpose_item<0, true>(P.w_down, DFF, DM, WDN, scr, r, lane, nullptr);
    }
    asm volatile("s_waitcnt vmcnt(0)" ::: "memory"); __syncthreads();
    if (threadIdx.x == 0) __hip_atomic_fetch_add((unsigned*)(P.ws + WS_BAR + 114688), 1u, __ATOMIC_RELAXED, __HIP_MEMORY_SCOPE_AGENT);
}

struct OrdOrder { pg8::StaticOrder S;
    DI bool next(int i, pg8::Unit& u) const { u.ord = i; return S.next(i, u); }
    DI void a_ready(const pg8::Unit&) const {} DI void done(const pg8::Unit&) const {} };
struct QuadOrder { int j, q, nN;
    DI bool next(int i, pg8::Unit& u) const {
        u.ord = i;
        if (nN == 4) { if (i >= 2) return false; u.pm = 2 * j + i; u.pn = q; return true; }
        const int e = 4 * i + q; if (e >= 2 * nN) return false;
        const int hi = e >= nN ? 1 : 0; u.pm = 2 * j + hi; u.pn = e - hi * nN; return true; }
    DI void a_ready(const pg8::Unit&) const {} DI void done(const pg8::Unit&) const {} };
DI void quad_sync(unsigned* flags, int vcu, int nquads, unsigned seq, int with_nb, int tid) {
    asm volatile("s_waitcnt vmcnt(0)" ::: "memory"); __syncthreads();
    if (tid < 64) {
        const int j = vcu >> 2; const unsigned myx = xb_xcc_id() + 1u;
        const int lo = ((with_nb & 1) ? max(j - 1, 0) : j) * 4, hi = ((with_nb & 2) ? min(j + 2, nquads) : j + 1) * 4;
        const int w = lo + tid; const bool act = w < hi;
        const unsigned px = act ? xb_ld(&flags[64 * w + 1]) : myx;
        if (!__all(px == myx)) { __builtin_amdgcn_fence(__ATOMIC_RELEASE, "agent"); asm volatile("s_waitcnt vmcnt(0)" ::: "memory"); }
        if (tid == 0) __hip_atomic_store(&flags[64 * vcu], seq, __ATOMIC_RELAXED, __HIP_MEMORY_SCOPE_AGENT);
        unsigned sp = 0;
        for (;;) { const unsigned v = act ? xb_ld(&flags[64 * w]) : seq; if (__all(v >= seq) || ++sp > (1u << 22)) break; __builtin_amdgcn_s_sleep(1); }
        __builtin_amdgcn_fence(__ATOMIC_ACQUIRE, "agent"); asm volatile("s_waitcnt vmcnt(0)" ::: "memory");
    }
    __syncthreads();
}
constexpr int RS_OFF = 131072 + 1024, RS_MAXU = 14;

struct EpiProj {
    static constexpr bool PERM = true, AFTER_DRAIN = false;
    bf16_t *QA, *KA, *VTA, *QB, *KB, *VTB; const float* rope;
    DI void operator()(const pg8::f32x4 (&acc)[2][2][4][2], const pg8::Unit& u, int wr, int wc, int fr, int fq) const {
        const int lane16 = fr + 16 * fq; (void)lane16;
        const int row0 = u.pm * 256 + wr * 64 + fr;
#pragma unroll
        for (int bj = 0; bj < 2; ++bj) {
            const int colbase = u.pn * 256 + bj * 128;
            const int cl = wc * 32 + fq * 8;
            int kind, c0, pitch; bf16_t* dst;
            if (colbase < 512)       { kind = 0; c0 = colbase;        dst = QA; pitch = 512; }
            else if (colbase < 640)  { kind = 1; c0 = colbase - 512;  dst = KA; pitch = 128; }
            else if (colbase < 768)  { kind = 2; c0 = colbase - 640;  dst = VTA; pitch = 0; }
            else if (colbase < 1280) { kind = 3; c0 = colbase - 768;  dst = QB; pitch = 512; }
            else if (colbase < 1792) { kind = 4; c0 = colbase - 1280; dst = KB; pitch = 512; }
            else                     { kind = 5; c0 = colbase - 1792; dst = VTB; pitch = 0; }
            const bool rope_w = (kind <= 1) && ((wc & 1) == 0);
            const float sc = (kind == 0 || kind == 3) ? QSCALE : 1.f;
#pragma unroll
            for (int ai = 0; ai < 2; ++ai)
#pragma unroll
                for (int m = 0; m < 4; ++m) {
                    const int row = row0 + ai * 128 + m * 16;
                    f32x4 v0 = acc[ai][bj][m][0], v1 = acc[ai][bj][m][1];
                    if (rope_w) {
                        const int pos = row & (SEQ - 1);
                        const f32x4 c0v = *(const f32x4*)(rope + pos * 16), c1v = *(const f32x4*)(rope + pos * 16 + 4);
                        const f32x4 s0v = *(const f32x4*)(rope + pos * 16 + 8), s1v = *(const f32x4*)(rope + pos * 16 + 12);
                        f32x4 p0, p1;
#pragma unroll
                        for (int j = 0; j < 4; ++j) { p0[j] = __shfl_xor(v0[j], 16); p1[j] = __shfl_xor(v1[j], 16); }
                        if (fq == 0) { v0 = v0 * c0v - p0 * s0v; v1 = v1 * c1v - p1 * s1v; }
                        else if (fq == 1) { v0 = v0 * c0v + p0 * s0v; v1 = v1 * c1v + p1 * s1v; }
                    }
                    v0 = v0 * sc; v1 = v1 * sc;
                    if (kind == 2 || kind == 5) {
                        const int b = row >> 13, s = row & (SEQ - 1);
                        const int cc = c0 + cl, head = cc >> 6, dim0 = cc & 63, nh = (kind == 2) ? 2 : 8;
                        bf16_t* vp = dst + (((size_t)(b * nh + head) * (SEQ / 8) + (s >> 3)) * 64 + dim0) * 8 + (s & 7);
#pragma unroll
                        for (int j = 0; j < 4; ++j) { vp[8 * j] = (bf16_t)(cvtpk(v0[j], 0.f) & 0xffffu); vp[8 * (4 + j)] = (bf16_t)(cvtpk(v1[j], 0.f) & 0xffffu); }
                    } else if (kind == 1 || kind == 4) {
                        const int b = row >> 13, s = row & (SEQ - 1);
                        const int cc = c0 + cl, head = cc >> 6, chunk = (cc & 63) >> 3, nh = (kind == 1) ? 2 : 8;
                        u32x4 w; w.x = cvtpk(v0[0], v0[1]); w.y = cvtpk(v0[2], v0[3]); w.z = cvtpk(v1[0], v1[1]); w.w = cvtpk(v1[2], v1[3]);
                        *(u32x4*)(dst + (((size_t)(b * nh + head) * 8 + chunk) * SEQ + s) * 8) = w;
                    } else {
                        u32x4 w; w.x = cvtpk(v0[0], v0[1]); w.y = cvtpk(v0[2], v0[3]); w.z = cvtpk(v1[0], v1[1]); w.w = cvtpk(v1[2], v1[3]);
                        *(u32x4*)(dst + (size_t)row * pitch + c0 + cl) = w;
                    }
                }
        }
    }
};

struct EpiOut {
    static constexpr bool PERM = true, AFTER_DRAIN = false;
    const float* x; bf16_t* h1b; float* ssq;
    DI void operator()(const pg8::f32x4 (&acc)[2][2][4][2], const pg8::Unit& u, int wr, int wc, int fr, int fq) const {
        const int row0 = u.pm * 256 + wr * 64 + fr;
#pragma unroll
        for (int ai = 0; ai < 2; ++ai)
#pragma unroll
            for (int m = 0; m < 4; ++m) {
                const int row = row0 + ai * 128 + m * 16; float ss = 0.f;
#pragma unroll
                for (int bj = 0; bj < 2; ++bj) {
                    const size_t off = (size_t)row * DM + u.pn * 256 + bj * 128 + wc * 32 + 8 * fq;
                    const f32x4 v0 = acc[ai][bj][m][0] + *(const f32x4*)(x + off), v1 = acc[ai][bj][m][1] + *(const f32x4*)(x + off + 4);
                    u32x4 w; w.x = cvtpk(v0[0], v0[1]); w.y = cvtpk(v0[2], v0[3]); w.z = cvtpk(v1[0], v1[1]); w.w = cvtpk(v1[2], v1[3]);
                    *(u32x4*)(h1b + off) = w;
                    ss += (v0[0] * v0[0] + v0[1] * v0[1]) + (v0[2] * v0[2] + v0[3] * v0[3]) + (v1[0] * v1[0] + v1[1] * v1[1]) + (v1[2] * v1[2] + v1[3] * v1[3]);
                }
                ss += __shfl_xor(ss, 16); ss += __shfl_xor(ss, 32);
                if (fq == 0) ssq[(size_t)row * 16 + u.pn * 4 + wc] = ss;
            }
    }
};

struct EpiGU {
    static constexpr bool PERM = true, AFTER_DRAIN = false;
    const LAS float* rsl; const float* cw; const float* cb; bf16_t* act; float* gb; float* ub;
    DI void operator()(const pg8::f32x4 (&acc)[2][2][4][2], const pg8::Unit& u, int wr, int wc, int fr, int fq) const {
        const int lane = fr + 16 * fq;
        const int f0 = u.pn * 128 + wc * 32 + 8 * fq;
        f32x4 w0[2], w1[2], w2[2], bb[2];
#pragma unroll
        for (int n = 0; n < 2; ++n) { w0[n] = *(const f32x4*)(cw + f0 + 4 * n); w1[n] = *(const f32x4*)(cw + DFF + f0 + 4 * n); w2[n] = *(const f32x4*)(cw + 2 * DFF + f0 + 4 * n); bb[n] = *(const f32x4*)(cb + f0 + 4 * n); }
#pragma unroll
        for (int ai = 0; ai < 2; ++ai) {
            const int rowb = u.pm * 256 + ai * 128 + wr * 64;
            const int blk64 = rowb >> 6;
            float rsv[4];
#pragma unroll
            for (int m = 0; m < 4; ++m) {
                rsv[m] = rsl[u.ord * 256 + ai * 128 + wr * 64 + 16 * m + fr];
            }
#pragma unroll
            for (int n = 0; n < 2; ++n) {
                f32x4 g[4], R[4], L[4];
#pragma unroll
                for (int m = 0; m < 4; ++m) { g[m] = acc[ai][0][m][n] * rsv[m];
#pragma unroll
                    for (int j = 0; j < 4; ++j) { R[m][j] = dpp_ror<0x121>(g[m][j]); L[m][j] = dpp_ror<0x12F>(g[m][j]); } }
#pragma unroll
                for (int m = 0; m < 4; ++m) {
                    const int row = rowb + 16 * m + fr;
                    const f32x4 uu = acc[ai][1][m][n] * rsv[m];
                    const f32x4 zero = {0.f, 0.f, 0.f, 0.f};
                    const f32x4 prev = (fr > 0) ? R[m] : (m > 0 ? R[m > 0 ? m - 1 : 0] : zero);
                    const f32x4 next = (fr < 15) ? L[m] : (m < 3 ? L[m < 3 ? m + 1 : 3] : zero);
                    const f32x4 cv = w0[n] * prev + w1[n] * g[m] + w2[n] * next + bb[n];
                    f32x4 a;
#pragma unroll
                    for (int j = 0; j < 4; ++j) a[j] = cv[j] * __builtin_amdgcn_rcpf(1.f + fexp2(-LOG2E * cv[j])) * uu[j];
                    u32x2 wv; wv.x = cvtpk(a[0], a[1]); wv.y = cvtpk(a[2], a[3]);
                    if (m == 0 && fr < 2) *(f32x4*)(gb + ((size_t)(blk64 * 4 + fr)) * DFF + f0 + 4 * n) = g[m];
                    if (m == 3 && fr >= 14) *(f32x4*)(gb + ((size_t)(blk64 * 4 + fr - 12)) * DFF + f0 + 4 * n) = g[m];
                    if (m == 0 && fr == 0) *(f32x4*)(ub + ((size_t)(blk64 * 2 + 0)) * DFF + f0 + 4 * n) = uu;
                    if (m == 3 && fr == 15) *(f32x4*)(ub + ((size_t)(blk64 * 2 + 1)) * DFF + f0 + 4 * n) = uu;
                    const bool edge = (m == 0 && fr == 0) || (m == 3 && fr == 15);
                    if (!edge) *(u32x2*)(act + (size_t)row * DFF + f0 + 4 * n) = wv;
                }
            }
        }
    }
};

struct EpiDownNorm {
    static constexpr bool PERM = true, AFTER_DRAIN = false;
    const bf16_t* h1b; float* out; const float* gfin; float* ssq2; unsigned* cnt;
    DI void operator()(pg8::f32x4 (&acc)[2][2][4][2], const pg8::Unit& u, int wr, int wc, int fr, int fq) const {
        const int row0 = u.pm * 256 + wr * 64 + fr;
#pragma unroll
        for (int ai = 0; ai < 2; ++ai)
#pragma unroll
            for (int m = 0; m < 4; ++m) {
                const int row = row0 + ai * 128 + m * 16; float ss = 0.f;
#pragma unroll
                for (int bj = 0; bj < 2; ++bj) {
                    const size_t off = (size_t)row * DM + u.pn * 256 + bj * 128 + wc * 32 + 8 * fq;
                    const u32x4 hb = *(const u32x4*)(h1b + off);
                    f32x4 r0, r1;
                    r0[0] = __uint_as_float(hb.x << 16); r0[1] = __uint_as_float(hb.x & 0xffff0000u); r0[2] = __uint_as_float(hb.y << 16); r0[3] = __uint_as_float(hb.y & 0xffff0000u);
                    r1[0] = __uint_as_float(hb.z << 16); r1[1] = __uint_as_float(hb.z & 0xffff0000u); r1[2] = __uint_as_float(hb.w << 16); r1[3] = __uint_as_float(hb.w & 0xffff0000u);
                    const f32x4 v0 = acc[ai][bj][m][0] + r0, v1 = acc[ai][bj][m][1] + r1;
                    acc[ai][bj][m][0] = v0; acc[ai][bj][m][1] = v1;
                    ss += (v0[0] * v0[0] + v0[1] * v0[1]) + (v0[2] * v0[2] + v0[3] * v0[3]) + (v1[0] * v1[0] + v1[1] * v1[1]) + (v1[2] * v1[2] + v1[3] * v1[3]);
                }
                ss += __shfl_xor(ss, 16); ss += __shfl_xor(ss, 32);
                if (fq == 0) __hip_atomic_store(ssq2 + ((size_t)u.pn * MROWS + row) * 4 + wc, ss, __ATOMIC_RELAXED, __HIP_MEMORY_SCOPE_AGENT);
            }
        asm volatile("s_waitcnt vmcnt(0)" ::: "memory");
        __builtin_amdgcn_s_barrier(); asm volatile("" ::: "memory");
        if (__builtin_amdgcn_readfirstlane(threadIdx.x >> 6) == 0) {
            unsigned* c = cnt + 64 * u.pm;
            if ((fr | fq) == 0) __hip_atomic_fetch_add(c, 1u, __ATOMIC_RELAXED, __HIP_MEMORY_SCOPE_AGENT);
            unsigned spins = 0;
            while ((unsigned)__builtin_amdgcn_readfirstlane(__hip_atomic_load(c, __ATOMIC_RELAXED, __HIP_MEMORY_SCOPE_AGENT)) < 4u) { __builtin_amdgcn_s_sleep(2); if (++spins > (1u << 22)) break; }
        }
        asm volatile("s_waitcnt vmcnt(0) lgkmcnt(0)" ::: "memory"); __builtin_amdgcn_s_barrier(); asm volatile("" ::: "memory");
#pragma unroll
        for (int ai = 0; ai < 2; ++ai)
#pragma unroll
            for (int m = 0; m < 4; ++m) {
                const int row = row0 + ai * 128 + m * 16;
                const unsigned long long* pp = (const unsigned long long*)(ssq2 + ((size_t)fq * MROWS + row) * 4);
                const unsigned long long pa = __hip_atomic_load(pp, __ATOMIC_RELAXED, __HIP_MEMORY_SCOPE_AGENT), pb = __hip_atomic_load(pp + 1, __ATOMIC_RELAXED, __HIP_MEMORY_SCOPE_AGENT);
                float t = (__uint_as_float((unsigned)pa) + __uint_as_float((unsigned)(pa >> 32))) + (__uint_as_float((unsigned)pb) + __uint_as_float((unsigned)(pb >> 32)));
                t += __shfl_xor(t, 16); t += __shfl_xor(t, 32);
                const float rs = rsqrtf(t * (1.f / DM) + EPS);
#pragma unroll
                for (int bj = 0; bj < 2; ++bj) {
                    const int col0 = u.pn * 256 + bj * 128 + wc * 32 + 8 * fq;
                    const size_t off = (size_t)row * DM + col0;
                    const f32x4 g0 = *(const f32x4*)(gfin + col0), g1 = *(const f32x4*)(gfin + col0 + 4);
                    *(f32x4*)(out + off) = acc[ai][bj][m][0] * rs * g0; *(f32x4*)(out + off + 4) = acc[ai][bj][m][1] * rs * g1;
                }
            }
    }
};

#define MFMA32(a, b, c) __builtin_amdgcn_mfma_f32_32x32x16_bf16((a), (b), (c), 0, 0, 0)
DI int perm_key(int rho) { return (rho & ~12) | ((rho & 4) << 1) | ((rho & 8) >> 1); }
constexpr int RPB_PAD = 64, RPB_FLOATS = RPB_PAD + 8 * 480 + 64;

template <int MODE>
DI void attend(const bf16_t* __restrict__ Qg, const bf16_t* __restrict__ Kg, const bf16_t* __restrict__ VTg, int b, int blk, int h, int lane, float m_init,
               const LAS float* rpbL, LAS float* ssqbuf, const float* __restrict__ gain, bf16_t* __restrict__ mix) {
    const int q = lane & 31, hh = lane >> 5;
    constexpr int KP = MODE == 0 ? 128 : 512, NHV = MODE == 0 ? 2 : 8;
    const int hk = MODE == 0 ? (h >> 2) : h;
    const size_t tokb = (size_t)b * SEQ;
    const int t0 = 64 * blk;
    bf16x8 qf[2][4];
    { const bf16_t* qp = Qg + (tokb + t0 + q) * 512 + h * 64 + 8 * hh;
#pragma unroll
      for (int qt = 0; qt < 2; ++qt)
#pragma unroll
          for (int t = 0; t < 4; ++t) qf[qt][t] = *(const bf16x8*)(qp + (size_t)qt * 32 * 512 + 16 * t); }
    f32x16 o[2][2];
#pragma unroll
    for (int a = 0; a < 2; ++a)
#pragma unroll
        for (int c = 0; c < 2; ++c)
#pragma unroll
            for (int i = 0; i < 16; ++i) o[a][c][i] = 0.f;
    float mrow[2] = {m_init, m_init}, lsum[2];
    lsum[0] = lsum[1] = (MODE == 0 && hh == 0) ? 1.f : 0.f;
    int st_lo, st_hi, rs = 0;
    if (MODE == 0) { st_lo = max(0, 4 - 2 * blk); st_hi = min(10, 260 - 2 * blk); }
    else { rs = min(max(blk - 4, 0), 120); st_lo = 0; st_hi = 16; }
    const bf16_t* kbase = Kg + (((size_t)(b * NHV + hk) * 8 + hh) * SEQ + perm_key(q)) * 8;
    const bf16_t* vbase = VTg + (((size_t)(b * NHV + hk) * (SEQ / 8) + hh) * 64 + q) * 8;
#define WTOK(st) (MODE == 0 ? (t0 - 128 + 32 * (st)) : ((rs + ((st) >> 1)) * 64 + 32 * ((st) & 1)))
#define LOADKV(kd, vd, w) do { _Pragma("unroll") for (int t = 0; t < 4; ++t) kd[t] = *(const bf16x8*)(kbase + ((size_t)(2 * t) * SEQ + (w)) * 8); \
        _Pragma("unroll") for (int dt = 0; dt < 2; ++dt) _Pragma("unroll") for (int s2 = 0; s2 < 2; ++s2) vd[dt][s2] = *(const bf16x8*)(vbase + ((size_t)(((w) >> 3) + 2 * s2) * 64 + 32 * dt) * 8); } while (0)
    bf16x8 kc[4], vc[2][2];
    { const int w = WTOK(st_lo); LOADKV(kc, vc, w); }
    for (int st = st_lo; st < st_hi; ++st) {
        bf16x8 kn[4], vn[2][2];
        { const int stn = min(st + 1, st_hi - 1); const int wn = WTOK(stn); LOADKV(kn, vn, wn); }
        const int w = WTOK(st);
        f32x16 s[2];
#pragma unroll
        for (int qt = 0; qt < 2; ++qt) {
#pragma unroll
            for (int i = 0; i < 16; ++i) s[qt][i] = 0.f;
#pragma unroll
            for (int t = 0; t < 4; ++t) s[qt] = MFMA32(kc[t], qf[qt][t], s[qt]);
        }
        if (MODE == 0) {
            if (st < 2 || st >= 8) {
#pragma unroll
                for (int qt = 0; qt < 2; ++qt) { const int base = w + 8 * hh - (t0 + 32 * qt + q) + 128;
#pragma unroll
                    for (int i = 0; i < 16; ++i) { const int d = base + 16 * (i >> 3) + (i & 7); if ((unsigned)d > 256u) s[qt][i] = -INFINITY; } }
            }
        } else {
            const int c = st & 1, roff = rs + (st >> 1) - blk + 7;
#pragma unroll
            for (int qt = 0; qt < 2; ++qt) { const int qc = 32 * qt + q, cs = min(max(qc - 8, 0), 48), kb = 32 * c + 8 * hh;
                const LAS float* bp = rpbL + RPB_PAD + h * 480 + roff * 32 + kb - qc + 15;
#pragma unroll
                for (int i = 0; i < 16; ++i) { const int off = 16 * (i >> 3) + (i & 7); const int rel = kb + off - cs; const float bias = bp[off];
                    s[qt][i] = (s[qt][i] + bias) + (((unsigned)rel < 16u) ? 0.f : -INFINITY); } }
        }
        bf16x8 pf[2][2];
#pragma unroll
        for (int qt = 0; qt < 2; ++qt) {
            float mx = s[qt][0];
#pragma unroll
            for (int i = 1; i < 16; ++i) mx = fmaxf(mx, s[qt][i]);
            if (__any(mx > mrow[qt] + 8.f)) {
                mx = fmaxf(mx, __shfl_xor(mx, 32));
                const float mnew2 = fmaxf(mrow[qt], mx), alpha = fexp2(mrow[qt] - mnew2);
                mrow[qt] = mnew2; lsum[qt] *= alpha;
#pragma unroll
                for (int i = 0; i < 16; ++i) { o[0][qt][i] *= alpha; o[1][qt][i] *= alpha; }
            }
            const float mnew = mrow[qt];
            float rsum = 0.f;
#pragma unroll
            for (int i = 0; i < 16; ++i) { const float p = fexp2(s[qt][i] - mnew); s[qt][i] = p; rsum += p; }
            lsum[qt] += rsum;
#pragma unroll
            for (int s2 = 0; s2 < 2; ++s2) { u32x4 pk; pk.x = cvtpk(s[qt][8 * s2 + 0], s[qt][8 * s2 + 1]); pk.y = cvtpk(s[qt][8 * s2 + 2], s[qt][8 * s2 + 3]);
                pk.z = cvtpk(s[qt][8 * s2 + 4], s[qt][8 * s2 + 5]); pk.w = cvtpk(s[qt][8 * s2 + 6], s[qt][8 * s2 + 7]); pf[qt][s2] = __builtin_bit_cast(bf16x8, pk); }
        }
#pragma unroll
        for (int dt = 0; dt < 2; ++dt)
#pragma unroll
            for (int qt = 0; qt < 2; ++qt)
#pragma unroll
                for (int s2 = 0; s2 < 2; ++s2) o[dt][qt] = MFMA32(vc[dt][s2], pf[qt][s2], o[dt][qt]);
#pragma unroll
        for (int t = 0; t < 4; ++t) kc[t] = kn[t];
#pragma unroll
        for (int dt = 0; dt < 2; ++dt)
#pragma unroll
            for (int s2 = 0; s2 < 2; ++s2) vc[dt][s2] = vn[dt][s2];
    }
#undef WTOK
#undef LOADKV
#pragma unroll
    for (int qt = 0; qt < 2; ++qt) {
        const float l = lsum[qt] + __shfl_xor(lsum[qt], 32), inv = 1.f / l;
        float ss = 0.f;
#pragma unroll
        for (int dt = 0; dt < 2; ++dt)
#pragma unroll
            for (int i = 0; i < 16; ++i) { const float v = o[dt][qt][i] * inv; o[dt][qt][i] = v; ss += v * v; }
        ss += __shfl_xor(ss, 32);
        if (hh == 0) ssqbuf[h * 64 + 32 * qt + q] = ss;
    }
    __syncthreads();
#pragma unroll
    for (int qt = 0; qt < 2; ++qt) {
        float tot = 0.f;
#pragma unroll
        for (int h2 = 0; h2 < 8; ++h2) tot += ssqbuf[h2 * 64 + 32 * qt + q];
        const float rsn = rsqrtf(tot * (1.f / 512.f) + EPS);
        bf16_t* mp = mix + (tokb + t0 + 32 * qt + q) * DM + h * 64 + 4 * hh;
#pragma unroll
        for (int dt = 0; dt < 2; ++dt)
#pragma unroll
            for (int g = 0; g < 4; ++g) {
                const f32x4 gv = *(const f32x4*)(gain + h * 64 + 32 * dt + 8 * g + 4 * hh);
                u32x2 w; w.x = cvtpk(o[dt][qt][4 * g + 0] * rsn * gv[0], o[dt][qt][4 * g + 1] * rsn * gv[1]);
                w.y = cvtpk(o[dt][qt][4 * g + 2] * rsn * gv[2], o[dt][qt][4 * g + 3] * rsn * gv[3]);
                *(u32x2*)(mp + 32 * dt + 8 * g) = w;
            }
    }
}

#define MFMA16(a, b, c) __builtin_amdgcn_mfma_f32_16x16x32_bf16((a), (b), (c), 0, 0, 0)
template <int MODE>
DI void attend16(const bf16_t* __restrict__ Qg, const bf16_t* __restrict__ Kg, const bf16_t* __restrict__ VTg, int b, int blk, int h, int lane, float sink2,
                 const LAS float* rpbL, LAS float* ssqbuf, const float* __restrict__ gain, bf16_t* __restrict__ mix) {
    constexpr int NG = MODE == 0 ? 9 : 8, BR = MODE == 0 ? 3 : 4, GS = MODE == 0 ? 32 : 64, NHV = MODE == 0 ? 2 : 8;
    const int ql = lane & 15, g = lane >> 4;
    const int hk = MODE == 0 ? (h >> 2) : h;
    const size_t tokb = (size_t)b * SEQ;
    const int t0 = 64 * blk;
    const int rs = min(max(blk - 4, 0), 120);
    bf16_t* mp0 = mix + (tokb + t0 + ql) * DM + h * 64 + 4 * g;
#pragma unroll
    for (int a = 0; a < 4; ++a) {
        const int wa = a == 0 ? 0 : a == 1 ? 8 : a == 2 ? 24 : 32;
        const int qc = 16 * a + ql;
        const int T0 = MODE == 0 ? (t0 + 16 * a - 128) : (rs * 64 + wa);
        bf16x8 qf[2];
        { const bf16_t* qp = Qg + (tokb + t0 + qc) * 512 + h * 64 + 8 * g; qf[0] = *(const bf16x8*)qp; qf[1] = *(const bf16x8*)(qp + 32); }
        const bf16_t* kp = Kg + ((long)((b * NHV + hk) * 8 + g) * SEQ + T0 + 8 * (ql >> 2) + (ql & 3)) * 8;
        const bf16_t* vp = VTg + (((long)(b * NHV + hk) * (SEQ / 8) + T0 / 8 + g) * 64 + ql) * 8;
        float mk[8];
        const LAS float* bp = rpbL + RPB_PAD + h * 480 + (rs - blk + 7) * 32 + (wa + 8 * g - qc + 15);
        if (MODE == 1) { const int cs = min(max(qc - 8, 0), 48), relb = wa + 8 * g - cs;
#pragma unroll
            for (int si = 0; si < 8; ++si) mk[si] = ((unsigned)(relb + si) < 16u) ? 0.f : -INFINITY; }
        f32x4 s[NG][2];
        float mx = MODE == 0 ? sink2 : -INFINITY;
#pragma unroll
        for (int ib = 0; ib < NG; ib += BR) {
            bf16x8 kf[BR][2][2];
#pragma unroll
            for (int i4 = 0; i4 < BR; ++i4)
#pragma unroll
                for (int tau = 0; tau < 2; ++tau)
#pragma unroll
                    for (int t = 0; t < 2; ++t) kf[i4][tau][t] = *(const bf16x8*)(kp + ((long)(4 * t) * SEQ + (ib + i4) * GS + 4 * tau) * 8);
#pragma unroll
            for (int i4 = 0; i4 < BR; ++i4)
#pragma unroll
                for (int tau = 0; tau < 2; ++tau) {
                    const int i = ib + i4;
                    f32x4 z;
                    if (MODE == 1) {
#pragma unroll
                        for (int j = 0; j < 4; ++j) z[j] = bp[32 * i + 4 * tau + j] + mk[4 * tau + j];
                    } else {
#pragma unroll
                        for (int j = 0; j < 4; ++j) { const int key = T0 + 32 * i + 8 * g + 4 * tau + j; const int dd = 32 * i + 8 * g + 4 * tau + j - ql;
                            z[j] = ((unsigned)dd <= 256u && (unsigned)key < (unsigned)SEQ) ? 0.f : -INFINITY; }
                    }
                    z = MFMA16(kf[i4][tau][0], qf[0], z); z = MFMA16(kf[i4][tau][1], qf[1], z); s[i][tau] = z;
                    mx = fmaxf(mx, fmaxf(fmaxf(z[0], z[1]), fmaxf(z[2], z[3])));
                }
        }
        mx = fmaxf(mx, __shfl_xor(mx, 16)); mx = fmaxf(mx, __shfl_xor(mx, 32));
        float lsum = 0.f; bf16x8 pf[NG];
#pragma unroll
        for (int i = 0; i < NG; ++i) {
            float p[8];
#pragma unroll
            for (int tau = 0; tau < 2; ++tau)
#pragma unroll
                for (int j = 0; j < 4; ++j) { p[4 * tau + j] = fexp2(s[i][tau][j] - mx); lsum += p[4 * tau + j]; }
            u32x4 pk; pk.x = cvtpk(p[0], p[1]); pk.y = cvtpk(p[2], p[3]); pk.z = cvtpk(p[4], p[5]); pk.w = cvtpk(p[6], p[7]); pf[i] = __builtin_bit_cast(bf16x8, pk);
        }
        lsum += __shfl_xor(lsum, 16); lsum += __shfl_xor(lsum, 32);
        if (MODE == 0) lsum += fexp2(sink2 - mx);
        f32x4 oo[4];
#pragma unroll
        for (int d = 0; d < 4; ++d) oo[d] = (f32x4){0.f, 0.f, 0.f, 0.f};
#pragma unroll
        for (int ib = 0; ib < NG; ib += BR) {
            bf16x8 vf[BR][4];
#pragma unroll
            for (int i4 = 0; i4 < BR; ++i4)
#pragma unroll
                for (int d = 0; d < 4; ++d) vf[i4][d] = *(const bf16x8*)(vp + ((long)((ib + i4) * (GS / 8)) * 64 + 16 * d) * 8);
#pragma unroll
            for (int i4 = 0; i4 < BR; ++i4)
#pragma unroll
                for (int d = 0; d < 4; ++d) oo[d] = MFMA16(vf[i4][d], pf[ib + i4], oo[d]);
        }
        const float inv = 1.f / lsum;
        float ss = 0.f;
#pragma unroll
        for (int d = 0; d < 4; ++d) {
            const f32x4 v = oo[d] * inv;
            ss += (v[0] * v[0] + v[1] * v[1]) + (v[2] * v[2] + v[3] * v[3]);
            u32x2 w; w.x = cvtpk(v[0], v[1]); w.y = cvtpk(v[2], v[3]);
            *(u32x2*)(mp0 + (size_t)(16 * a) * DM + 16 * d) = w;
        }
        ss += __shfl_xor(ss, 16); ss += __shfl_xor(ss, 32);
        if (g == 0) ssqbuf[h * 64 + 16 * a + ql] = ss;
    }
    __syncthreads();
#pragma unroll
    for (int a = 0; a < 4; ++a) {
        float tot = 0.f;
#pragma unroll
        for (int h2 = 0; h2 < 8; ++h2) tot += ssqbuf[h2 * 64 + 16 * a + ql];
        const float rsn = rsqrtf(tot * (1.f / 512.f) + EPS);
#pragma unroll
        for (int d = 0; d < 4; ++d) {
            const f32x4 gv = *(const f32x4*)(gain + h * 64 + 16 * d + 4 * g);
            u32x2* p = (u32x2*)(mp0 + (size_t)(16 * a) * DM + 16 * d);
            const u32x2 r = *p;
            u32x2 w; w.x = cvtpk(__uint_as_float(r.x << 16) * rsn * gv[0], __uint_as_float(r.x & 0xffff0000u) * rsn * gv[1]);
            w.y = cvtpk(__uint_as_float(r.y << 16) * rsn * gv[2], __uint_as_float(r.y & 0xffff0000u) * rsn * gv[3]);
            *p = w;
        }
    }
}

DI bf16x8 scale_pf(bf16x8 p, float alpha) {
    const u32x4 r = __builtin_bit_cast(u32x4, p); u32x4 w;
    w.x = cvtpk(__uint_as_float(r.x << 16) * alpha, __uint_as_float(r.x & 0xffff0000u) * alpha); w.y = cvtpk(__uint_as_float(r.y << 16) * alpha, __uint_as_float(r.y & 0xffff0000u) * alpha);
    w.z = cvtpk(__uint_as_float(r.z << 16) * alpha, __uint_as_float(r.z & 0xffff0000u) * alpha); w.w = cvtpk(__uint_as_float(r.w << 16) * alpha, __uint_as_float(r.w & 0xffff0000u) * alpha);
    return __builtin_bit_cast(bf16x8, w);
}
template <int DELTA>
DI void attend_b_dual(const bf16_t* __restrict__ Qg, const bf16_t* __restrict__ Kg, const bf16_t* __restrict__ VTg, int b, int blk0, int h, int lane,
                      const LAS float* rpbL, LAS float* ssq0, LAS float* ssq1, bf16_t* __restrict__ mix) {
    constexpr int NR = 8 + DELTA, BR = DELTA ? 5 : 4;
    const int ql = lane & 15, g = lane >> 4;
    const int t0 = 64 * blk0;
    const int rs0 = min(max(blk0 - 4, 0), 120);
    bf16_t* mp0 = mix + ((size_t)b * SEQ + t0 + ql) * DM + h * 64 + 4 * g;
    const char* Kc = (const char*)Kg; const char* Vc = (const char*)VTg; const char* Qc = (const char*)Qg;
    const unsigned kb0 = (unsigned)(((((b * 8 + h) * 8 + g)) * SEQ + rs0 * 64 + 8 * (ql >> 2) + (ql & 3)) * 16);
    const unsigned vb0 = (unsigned)((((b * 8 + h) * (SEQ / 8) + rs0 * 8 + g) * 64 + ql) * 16);
    const unsigned qb0 = (unsigned)(((b * SEQ + t0 + ql) * 512 + h * 64 + 8 * g) * 2);
#pragma unroll
    for (int a = 0; a < 4; ++a) {
        const int wa = a == 0 ? 0 : a == 1 ? 8 : a == 2 ? 24 : 32;
        const int qc = 16 * a + ql;
        bf16x8 qf0[2], qf1[2];
        { unsigned q0_ = qb0; asm volatile("" : "+v"(q0_));
          qf0[0] = *(const bf16x8*)(Qc + (q0_ + (unsigned)(a * 16 * 1024))); qf0[1] = *(const bf16x8*)(Qc + (q0_ + (unsigned)(a * 16 * 1024 + 64)));
          qf1[0] = *(const bf16x8*)(Qc + (q0_ + (unsigned)((64 + a * 16) * 1024))); qf1[1] = *(const bf16x8*)(Qc + (q0_ + (unsigned)((64 + a * 16) * 1024 + 64))); }
        const int cs = min(max(qc - 8, 0), 48), relb = wa + 8 * g - cs;
        float mk[8];
#pragma unroll
        for (int si = 0; si < 8; ++si) mk[si] = ((unsigned)(relb + si) < 16u) ? 0.f : -INFINITY;
        const LAS float* bp0 = rpbL + RPB_PAD + h * 480 + (rs0 - blk0 + 7) * 32 + (wa + 8 * g - qc + 15);
        const LAS float* bp1 = bp0 + (DELTA - 1) * 32;
        float mref0 = -INFINITY, mref1 = -INFINITY, l0 = 0.f, l1 = 0.f; bf16x8 pf0[8], pf1[8];
#pragma unroll
        for (int ib = 0; ib < NR; ib += BR) {
            bf16x8 kf[BR][2][2];
            { unsigned k0_ = kb0; asm volatile("" : "+v"(k0_));
#pragma unroll
              for (int i4 = 0; i4 < BR; ++i4)
#pragma unroll
                  for (int tau = 0; tau < 2; ++tau)
#pragma unroll
                      for (int t = 0; t < 2; ++t) if (ib + i4 < NR) kf[i4][tau][t] = *(const bf16x8*)(Kc + (k0_ + (unsigned)(wa * 16 + (4 * t) * SEQ * 16 + ((ib + i4) * 64 + 4 * tau) * 16))); }
            f32x4 sa[BR][2], sb[BR][2];
            float bm0 = -INFINITY, bm1 = -INFINITY;
#pragma unroll
            for (int i4 = 0; i4 < BR; ++i4)
#pragma unroll
                for (int tau = 0; tau < 2; ++tau) {
                    const int iu = ib + i4, i1 = iu - DELTA;
                    if (iu < 8) { f32x4 z;
#pragma unroll
                        for (int j = 0; j < 4; ++j) z[j] = bp0[32 * iu + 4 * tau + j] + mk[4 * tau + j];
                        z = MFMA16(kf[i4][tau][0], qf0[0], z); z = MFMA16(kf[i4][tau][1], qf0[1], z); sa[i4][tau] = z; bm0 = fmaxf(bm0, fmaxf(fmaxf(z[0], z[1]), fmaxf(z[2], z[3]))); }
                    if (iu < NR && i1 >= 0 && i1 < 8) { f32x4 z;
#pragma unroll
                        for (int j = 0; j < 4; ++j) z[j] = bp1[32 * i1 + 4 * tau + j] + mk[4 * tau + j];
                        z = MFMA16(kf[i4][tau][0], qf1[0], z); z = MFMA16(kf[i4][tau][1], qf1[1], z); sb[i4][tau] = z; bm1 = fmaxf(bm1, fmaxf(fmaxf(z[0], z[1]), fmaxf(z[2], z[3]))); }
                }
            if (__any(bm0 > mref0 + 64.f)) {
                float m = fmaxf(bm0, __shfl_xor(bm0, 16)); m = fmaxf(m, __shfl_xor(m, 32)); m = fmaxf(m, mref0);
                const float alpha = fexp2(mref0 - m); mref0 = m; l0 *= alpha;
#pragma unroll
                for (int i = 0; i < 8; ++i) if (i < ib) pf0[i] = scale_pf(pf0[i], alpha);
            }
            if (__any(bm1 > mref1 + 64.f)) {
                float m = fmaxf(bm1, __shfl_xor(bm1, 16)); m = fmaxf(m, __shfl_xor(m, 32)); m = fmaxf(m, mref1);
                const float alpha = fexp2(mref1 - m); mref1 = m; l1 *= alpha;
#pragma unroll
                for (int i = 0; i < 8; ++i) if (i < ib - DELTA) pf1[i] = scale_pf(pf1[i], alpha);
            }
#pragma unroll
            for (int i4 = 0; i4 < BR; ++i4) {
                const int iu = ib + i4, i1 = iu - DELTA;
                if (iu < 8) { float p[8];
#pragma unroll
                    for (int tau = 0; tau < 2; ++tau)
#pragma unroll
                        for (int j = 0; j < 4; ++j) { p[4 * tau + j] = fexp2(sa[i4][tau][j] - mref0); l0 += p[4 * tau + j]; }
                    u32x4 pk; pk.x = cvtpk(p[0], p[1]); pk.y = cvtpk(p[2], p[3]); pk.z = cvtpk(p[4], p[5]); pk.w = cvtpk(p[6], p[7]); pf0[iu < 8 ? iu : 0] = __builtin_bit_cast(bf16x8, pk); }
                if (iu < NR && i1 >= 0 && i1 < 8) { float p[8];
#pragma unroll
                    for (int tau = 0; tau < 2; ++tau)
#pragma unroll
                        for (int j = 0; j < 4; ++j) { p[4 * tau + j] = fexp2(sb[i4][tau][j] - mref1); l1 += p[4 * tau + j]; }
                    u32x4 pk; pk.x = cvtpk(p[0], p[1]); pk.y = cvtpk(p[2], p[3]); pk.z = cvtpk(p[4], p[5]); pk.w = cvtpk(p[6], p[7]); pf1[(i1 >= 0 && i1 < 8) ? i1 : 0] = __builtin_bit_cast(bf16x8, pk); }
            }
        }
        l0 += __shfl_xor(l0, 16); l0 += __shfl_xor(l0, 32);
        l1 += __shfl_xor(l1, 16); l1 += __shfl_xor(l1, 32);
        f32x4 oo0[4], oo1[4];
#pragma unroll
        for (int d = 0; d < 4; ++d) { oo0[d] = (f32x4){0.f, 0.f, 0.f, 0.f}; oo1[d] = (f32x4){0.f, 0.f, 0.f, 0.f}; }
#pragma unroll
        for (int ib = 0; ib < NR; ib += BR) {
            bf16x8 vf[BR][4];
            { unsigned v0_ = vb0; asm volatile("" : "+v"(v0_));
#pragma unroll
              for (int i4 = 0; i4 < BR; ++i4)
#pragma unroll
                  for (int d = 0; d < 4; ++d) if (ib + i4 < NR) vf[i4][d] = *(const bf16x8*)(Vc + (v0_ + (unsigned)((wa / 8) * 1024 + ((ib + i4) * 8 * 64 + 16 * d) * 16))); }
#pragma unroll
            for (int i4 = 0; i4 < BR; ++i4) {
                const int iu = ib + i4, i1 = iu - DELTA;
#pragma unroll
                for (int d = 0; d < 4; ++d) {
                    if (iu < 8) oo0[d] = MFMA16(vf[i4][d], pf0[iu < 8 ? iu : 0], oo0[d]);
                    if (iu < NR && i1 >= 0 && i1 < 8) oo1[d] = MFMA16(vf[i4][d], pf1[(i1 >= 0 && i1 < 8) ? i1 : 0], oo1[d]);
                }
            }
        }
#pragma unroll
        for (int u = 0; u < 2; ++u) {
            const float inv = 1.f / (u == 0 ? l0 : l1);
            float ss = 0.f;
#pragma unroll
            for (int d = 0; d < 4; ++d) {
                const f32x4 v = (u == 0 ? oo0[d] : oo1[d]) * inv;
                ss += (v[0] * v[0] + v[1] * v[1]) + (v[2] * v[2] + v[3] * v[3]);
                u32x2 w; w.x = cvtpk(v[0], v[1]); w.y = cvtpk(v[2], v[3]);
                *(u32x2*)(mp0 + (size_t)(64 * u + 16 * a) * DM + 16 * d) = w;
            }
            ss += __shfl_xor(ss, 16); ss += __shfl_xor(ss, 32);
            if (g == 0) (u == 0 ? ssq0 : ssq1)[h * 64 + 16 * a + ql] = ss;
        }
    }
}
DI void rescale_b(int b, int blk, int h, int lane, const LAS float* ssqbuf, const float* __restrict__ gain, bf16_t* __restrict__ mix) {
    const int ql = lane & 15, g = lane >> 4;
    const size_t tokb = (size_t)b * SEQ; const int t0 = 64 * blk;
    bf16_t* mp0 = mix + (tokb + t0 + ql) * DM + h * 64 + 4 * g;
#pragma unroll
    for (int a = 0; a < 4; ++a) {
        float tot = 0.f;
#pragma unroll
        for (int h2 = 0; h2 < 8; ++h2) tot += ssqbuf[h2 * 64 + 16 * a + ql];
        const float rsn = rsqrtf(tot * (1.f / 512.f) + EPS);
#pragma unroll
        for (int d = 0; d < 4; ++d) {
            const f32x4 gv = *(const f32x4*)(gain + h * 64 + 16 * d + 4 * g);
            u32x2* p = (u32x2*)(mp0 + (size_t)(16 * a) * DM + 16 * d);
            const u32x2 r = *p;
            u32x2 w; w.x = cvtpk(__uint_as_float(r.x << 16) * rsn * gv[0], __uint_as_float(r.x & 0xffff0000u) * rsn * gv[1]);
            w.y = cvtpk(__uint_as_float(r.y << 16) * rsn * gv[2], __uint_as_float(r.y & 0xffff0000u) * rsn * gv[3]);
            *p = w;
        }
    }
}

DI void attn_table(const Ptrs& P, LAS unsigned char* lds, int tid) {
    LAS float* rpbL = (LAS float*)lds;
    for (int i = tid; i < RPB_FLOATS; i += NTHREADS) rpbL[i] = 0.f;
    __syncthreads();
    for (int i = tid; i < 8 * 15 * 31; i += NTHREADS) { const int hd = i / 465, rem = i % 465, ro = rem / 31, co = rem % 31; rpbL[RPB_PAD + hd * 480 + ro * 32 + co] = P.rpb[i] * LOG2E; }
    __syncthreads();
}
DI void phase_attn(const Ptrs& P, LAS unsigned char* lds, int vcu, int G, int wave, int lane, int tid, bool table_ready) {
    LAS float* rpbL = (LAS float*)lds;
    LAS float* ssqA = (LAS float*)(lds + 32768);
    LAS float* ssqB = (LAS float*)(lds + 32768 + 4096);
    if (!table_ready) attn_table(P, lds, tid);
    const bf16_t* QA = (const bf16_t*)(P.ws + WS_QA); const bf16_t* KA = (const bf16_t*)(P.ws + WS_KA); const bf16_t* VTA = (const bf16_t*)(P.ws + WS_VTA);
    const bf16_t* QB = (const bf16_t*)(P.ws + WS_QB); const bf16_t* KB = (const bf16_t*)(P.ws + WS_KB); const bf16_t* VTB = (const bf16_t*)(P.ws + WS_VTB);
    bf16_t* MIX = (bf16_t*)(P.ws + WS_MIX);
    constexpr int NUNITS = NBATCH * (SEQ / 64);
    const int per = (NUNITS + G - 1) / G;
    const float sinkv = P.sink[wave] * LOG2E;
    if (per == 2) {
        const int unit0 = vcu * 2;
        if (unit0 < NUNITS) {
            const int b = unit0 >> 7, blk0 = unit0 & 127;
#pragma unroll 1
            for (int u = 0; u < 2; ++u) { int ln = lane; asm volatile("" : "+v"(ln)); attend<0>(QA, KA, VTA, b, blk0 + u, wave, ln, sinkv, rpbL, ssqA, P.norm_a, MIX); }
            LAS float* sB1 = ssqB + 512;
            int ln2 = lane; asm volatile("" : "+v"(ln2));
            const int rs0 = min(max(blk0 - 4, 0), 120), rs1 = min(max(blk0 - 3, 0), 120);
            if (rs1 != rs0) attend_b_dual<1>(QB, KB, VTB, b, blk0, wave, ln2, rpbL, ssqB, sB1, MIX + 512);
            else attend_b_dual<0>(QB, KB, VTB, b, blk0, wave, ln2, rpbL, ssqB, sB1, MIX + 512);
            __syncthreads();
            rescale_b(b, blk0, wave, lane, ssqB, P.norm_b, MIX + 512);
            rescale_b(b, blk0 + 1, wave, lane, sB1, P.norm_b, MIX + 512);
        }
    } else
    for (int uu = 0; uu < per; ++uu) {
        const int unit = vcu * per + uu; if (unit >= NUNITS) break;
        const int b = unit >> 7, blk = unit & 127;
        int ln = lane; asm volatile("" : "+v"(ln));
        attend<0>(QA, KA, VTA, b, blk, wave, ln, sinkv, rpbL, ssqA, P.norm_a, MIX);
        int ln2 = lane; asm volatile("" : "+v"(ln2));
        attend16<1>(QB, KB, VTB, b, blk, wave, ln2, 0.f, rpbL, ssqB, P.norm_b, MIX + 512);
    }
    __syncthreads();
}

DI void fixup_rows(const Ptrs& P, int rowi0, int nrows, int t, int nthr) {
    const float* gb = (const float*)(P.ws + WS_GB); const float* ub = (const float*)(P.ws + WS_UB); bf16_t* act = (bf16_t*)(P.ws + WS_ACT);
    constexpr int F4 = DFF / 4, NB = 3;
    for (int it0 = t; it0 < nrows * F4; it0 += NB * nthr) {
        f32x4 gp[NB], gc[NB], gn[NB], uv[NB], w0[NB], w1[NB], w2[NB], bb[NB]; int row[NB], fo[NB]; bool live[NB];
#pragma unroll
        for (int k = 0; k < NB; ++k) {
            const int it = it0 + k * nthr; live[k] = it < nrows * F4; const int itc = live[k] ? it : it0;
            const int rowi = rowi0 + itc / F4, f = 4 * (itc % F4), blk64 = rowi >> 1, side = rowi & 1;
            const int c = blk64 * 4 + 3 * side;
            const bool zp = side == 0 && (blk64 & 127) == 0, zn = side == 1 && (blk64 & 127) == 127;
            gp[k] = *(const f32x4*)(gb + (size_t)(zp ? c : c - 1) * DFF + f); gc[k] = *(const f32x4*)(gb + (size_t)c * DFF + f); gn[k] = *(const f32x4*)(gb + (size_t)(zn ? c : c + 1) * DFF + f);
            uv[k] = *(const f32x4*)(ub + (size_t)rowi * DFF + f);
            w0[k] = *(const f32x4*)(P.conv_w + f); w1[k] = *(const f32x4*)(P.conv_w + DFF + f); w2[k] = *(const f32x4*)(P.conv_w + 2 * DFF + f); bb[k] = *(const f32x4*)(P.conv_b + f);
            if (zp) w0[k] = (f32x4){0.f, 0.f, 0.f, 0.f};
            if (zn) w2[k] = (f32x4){0.f, 0.f, 0.f, 0.f};
            row[k] = blk64 * 64 + 63 * side; fo[k] = f;
        }
#pragma unroll
        for (int k = 0; k < NB; ++k) {
            const f32x4 cv = w0[k] * gp[k] + w1[k] * gc[k] + w2[k] * gn[k] + bb[k];
            f32x4 a;
#pragma unroll
            for (int j = 0; j < 4; ++j) a[j] = cv[j] * __builtin_amdgcn_rcpf(1.f + fexp2(-LOG2E * cv[j])) * uv[k][j];
            u32x2 w; w.x = cvtpk(a[0], a[1]); w.y = cvtpk(a[2], a[3]);
            if (live[k]) *(u32x2*)(act + (size_t)row[k] * DFF + fo[k]) = w;
        }
    }
}

DI void phase_final(const Ptrs& P, int vcu, int G, int wave, int lane) {
    const int gw = vcu * NWAVES + wave, NGW = G * NWAVES;
    f32x4 gm[4];
#pragma unroll
    for (int j = 0; j < 4; ++j) gm[j] = ((const f32x4*)P.norm_final)[lane + 64 * j];
    for (int m = gw; m < MROWS; m += NGW) {
        f32x4* xr = (f32x4*)(P.out + (size_t)m * DM) + lane;
        f32x4 v[4]; float s = 0.f;
#pragma unroll
        for (int j = 0; j < 4; ++j) { v[j] = xr[64 * j]; s += (v[j].x * v[j].x + v[j].y * v[j].y) + (v[j].z * v[j].z + v[j].w * v[j].w); }
        const float rs = rsqrtf(wave_sum(s) * (1.f / DM) + EPS);
#pragma unroll
        for (int j = 0; j < 4; ++j) xr[64 * j] = v[j] * rs * gm[j];
    }
}

struct Args { const float* in[15]; float* out; unsigned char* ws; int ph_lo, ph_hi; };
static_assert(sizeof(Args) == 15 * 8 + 8 + 8 + 8, "Args has no padding");

__global__ void __launch_bounds__(NTHREADS, 2) hybrid_fwd(Args a) {
    extern __shared__ __attribute__((aligned(16))) unsigned char lds_raw[];
    LAS unsigned char* lds = (LAS unsigned char*)lds_raw;
    const int tid = threadIdx.x, lane = tid & 63, wave = __builtin_amdgcn_readfirstlane(tid >> 6);
    const int G = gridDim.x, bx = blockIdx.x;
    const int vcu = (G % 8 == 0) ? (bx % 8) * (G / 8) + bx / 8 : bx;
    Ptrs P;
    P.x = a.in[0]; P.norm_mix = a.in[1]; P.w_in = a.in[2]; P.sink = a.in[3]; P.rpb = a.in[4]; P.norm_a = a.in[5]; P.norm_b = a.in[6]; P.w_out = a.in[7];
    P.norm_ffn = a.in[8]; P.w_gate = a.in[9]; P.w_up = a.in[10]; P.conv_w = a.in[11]; P.conv_b = a.in[12]; P.w_down = a.in[13]; P.norm_final = a.in[14];
    P.out = a.out; P.ws = a.ws;
    const int lo = a.ph_lo, hi = a.ph_hi;
#define IN(k) (lo <= (k) && (k) < hi)
#ifndef PROBE_REPEAT
#define PROBE_REPEAT -1
#endif
    unsigned char* ws = a.ws;
#if MK_N_LAUNCHES == 1
    volatile LAS unsigned* st = (volatile LAS unsigned*)(lds + 131072);
    unsigned* barw = (unsigned*)(ws + WS_BAR);
    if (tid < 2) st[tid] = 0u;
    __syncthreads();
    XcdBarrier xb = xcd_barrier_post(barw, st);
    unsigned* qflags = (unsigned*)(ws + WS_BAR + 16384 + 32768);
    if (tid == 0) __hip_atomic_store(&qflags[64 * vcu + 1], xb_xcc_id() + 1u, __ATOMIC_RELAXED, __HIP_MEMORY_SCOPE_AGENT);
    const bool quads = (G == 256);
#define QSYNC(k, seq, nb) do { if (IN(k) && IN((k) + 1)) { if (quads) quad_sync(qflags, vcu, G / 4, (seq), (nb), tid); else xcd_barrier(xb); } } while (0)
#define SEAM(k) do { if (IN(k) && IN((k) + 1)) { xcd_barrier(xb); } } while (0)
#else
#define SEAM(k) do { } while (0)
#define QSYNC(k, seq, nb) do { } while (0)
    const bool quads = (G == 256);
#endif
    if (IN(0)) {
#if MK_N_LAUNCHES == 1
        if (quads) {
            unsigned* wcnt = (unsigned*)(ws + WS_BAR + 114688 + 128);
            phase0_local(P, lds, vcu, G, wave, lane, tid, wcnt);
            if (IN(1)) {
                if (tid == 0) { unsigned sp = 0; while (xb_ld(wcnt) < (unsigned)G) { __builtin_amdgcn_s_sleep(2); if (++sp > (1u << 22)) break; } }
                quad_sync(qflags, vcu, G / 4, 1u, 0, tid);
            }
        } else
#endif
        { phase0(P, lds, vcu, G, wave, lane, tid); __syncthreads(); SEAM(0); }
    }
    if (IN(1)) {
        pg8::Gemm g{(const bf16_t*)(ws + WS_XN), (const bf16_t*)(ws + WS_WIN), MROWS, DIN, DM}; pg8::StaticOrder S; S.init(MROWS, DIN, G, bx);
        EpiProj E{(bf16_t*)(ws + WS_QA), (bf16_t*)(ws + WS_KA), (bf16_t*)(ws + WS_VTA), (bf16_t*)(ws + WS_QB), (bf16_t*)(ws + WS_KB), (bf16_t*)(ws + WS_VTB), (const float*)(ws + WS_ROPE)};
        if (quads) {
            QuadOrder Q{vcu >> 2, vcu & 3, DIN / 256};
            pg8::gemm_phase<EpiProj, QuadOrder, true, true>(lds, g, Q, E);
            if ((vcu & 3) >= 2) ffn_weights(P, lds, (vcu >> 2) * 2 + (vcu & 1), G / 2, wave, lane);
        } else {
            pg8::gemm_phase<EpiProj, pg8::StaticOrder, true, true>(lds, g, S, E);
            { constexpr int NU = (MROWS / 256) * (DIN / 256); const int rem = NU % G;
              if (rem == 0) ffn_weights(P, lds, bx, G, wave, lane); else if (bx >= rem) ffn_weights(P, lds, bx - rem, G - rem, wave, lane); }
        }
        if (IN(2)) { __syncthreads(); attn_table(P, lds, tid); }
        QSYNC(1, 2u, ((vcu & 3) < 2 ? 1 : 2));
    }
    if (IN(2)) { phase_attn(P, lds, vcu, G, wave, lane, tid, IN(1)); QSYNC(2, 3u, 0); }
    if (IN(3)) {
        pg8::Gemm g{(const bf16_t*)(ws + WS_MIX), (const bf16_t*)(ws + WS_WOUT), MROWS, DM, DM}; pg8::StaticOrder S; S.init(MROWS, DM, G, bx);
        EpiOut E{P.x, (bf16_t*)(ws + WS_H1B), (float*)(ws + WS_SSQ1)};
        if (quads) { QuadOrder Q{vcu >> 2, vcu & 3, 4}; pg8::gemm_phase<EpiOut, QuadOrder, true, true>(lds, g, Q, E); }
        else pg8::gemm_phase<EpiOut, pg8::StaticOrder, true, true>(lds, g, S, E);
#if MK_N_LAUNCHES == 1
        if (quads && IN(4)) { if (tid == 0) { unsigned sp = 0; while (xb_ld((unsigned*)(ws + WS_BAR + 114688)) < (unsigned)(G / 2)) { __builtin_amdgcn_s_sleep(2); if (++sp > (1u << 22)) break; } } }
#endif
        QSYNC(3, 4u, 0);
    }
    if (IN(4)) {
        pg8::Gemm g{(const bf16_t*)(ws + WS_H1B), (const bf16_t*)(ws + WS_WGU), MROWS, NGU, DM}; pg8::StaticOrder S; S.init(MROWS, NGU, G, bx);
        LAS float* rsl = (LAS float*)(lds + RS_OFF);
        QuadOrder Q{vcu >> 2, vcu & 3, NGU / 256};
        { const float* ssq1 = (const float*)(ws + WS_SSQ1); pg8::Unit u0;
          for (int i = 0; i < RS_MAXU && (quads ? Q.next(i, u0) : S.next(i, u0)); ++i) if (tid < 256) {
              const f32x4* pz = (const f32x4*)(ssq1 + (size_t)(u0.pm * 256 + tid) * 16);
              const f32x4 p0 = pz[0], p1 = pz[1], p2 = pz[2], p3 = pz[3];
              const float t = (((p0.x + p0.y) + (p0.z + p0.w)) + ((p1.x + p1.y) + (p1.z + p1.w))) + (((p2.x + p2.y) + (p2.z + p2.w)) + ((p3.x + p3.y) + (p3.z + p3.w)));
              rsl[i * 256 + tid] = rsqrtf(t * (1.f / DM) + EPS); }
          __syncthreads(); }
        EpiGU E{rsl, P.conv_w, P.conv_b, (bf16_t*)(ws + WS_ACT), (float*)(ws + WS_GB), (float*)(ws + WS_UB)};
        if (quads) pg8::gemm_phase<EpiGU, QuadOrder, true, true>(lds, g, Q, E);
        else { OrdOrder SO{S}; pg8::gemm_phase<EpiGU, OrdOrder, true, true>(lds, g, SO, E); }
        QSYNC(4, 5u, ((vcu & 3) == 0 ? 1 : (vcu & 3) == 3 ? 2 : 0));
    }
    if (IN(5)) {
        QuadOrder Q{vcu >> 2, vcu & 3, 4};
        if (quads && MK_N_LAUNCHES == 1) {
            fixup_rows(P, 16 * (vcu >> 2) + 4 * (vcu & 3), 4, tid, NTHREADS);
#if MK_N_LAUNCHES == 1
            quad_sync(qflags, vcu, G / 4, 6u, 0, tid);
#endif
        } else {
          pg8::StaticOrder S0; S0.init(MROWS, DM, G, bx); pg8::Unit u0; int last = -1;
          for (int i = 0; S0.next(i, u0); ++i) { if (u0.pm != last) fixup_rows(P, 8 * u0.pm, 8, tid, NTHREADS); last = u0.pm; }
          asm volatile("s_waitcnt vmcnt(0)" ::: "memory"); __syncthreads(); }
        pg8::Gemm g{(const bf16_t*)(ws + WS_ACT), (const bf16_t*)(ws + WS_WDN), MROWS, DM, DFF}; pg8::StaticOrder S; S.init(MROWS, DM, G, bx);
        EpiDownNorm E{(const bf16_t*)(ws + WS_H1B), P.out, P.norm_final, (float*)(ws + WS_SSQ2), (unsigned*)(ws + WS_BAR + 16384)};
        if (quads) pg8::gemm_phase<EpiDownNorm, QuadOrder, true, true>(lds, g, Q, E);
        else pg8::gemm_phase<EpiDownNorm, pg8::StaticOrder, true, true>(lds, g, S, E);
    }
#undef IN
#undef SEAM
#undef QSYNC
}

extern "C" void kernel_launch(void* const* d_in, const int* in_sizes, int n_in, void* d_out, int out_size, void* d_ws, size_t ws_size, hipStream_t stream) {
    static int grid = 0;
    if (grid == 0) {
        if (n_in != 15 || in_sizes[0] != MROWS * DM || out_size != MROWS * DM || ws_size < WS_END) {
            fprintf(stderr, "kernel_launch: unexpected shapes (n_in %d, in0 %d, out %d, ws %zu); nothing launched\n", n_in, n_in > 0 ? in_sizes[0] : -1, out_size, ws_size); grid = -1; return; }
        int dev = 0, cus = 0, per_cu = 0;
        if (hipGetDevice(&dev) != hipSuccess || hipDeviceGetAttribute(&cus, hipDeviceAttributeMultiprocessorCount, dev) != hipSuccess) { fprintf(stderr, "kernel_launch: device query failed\n"); grid = -1; return; }
        if (hipFuncSetAttribute((const void*)hybrid_fwd, hipFuncAttributeMaxDynamicSharedMemorySize, LDS_BYTES) != hipSuccess) { fprintf(stderr, "kernel_launch: hipFuncSetAttribute failed\n"); grid = -1; return; }
        if (hipOccupancyMaxActiveBlocksPerMultiprocessor(&per_cu, (const void*)hybrid_fwd, NTHREADS, LDS_BYTES) != hipSuccess || per_cu < 1) {
            fprintf(stderr, "kernel_launch: occupancy query reports %d workgroups per CU; nothing launched\n", per_cu); (void)hipGetLastError(); grid = -1; return; }
        grid = cus;
    }
    if (grid < 0) return;
    Args a{};
    for (int i = 0; i < 15; ++i) a.in[i] = (const float*)d_in[i];
    a.out = (float*)d_out; a.ws = (unsigned char*)d_ws;
    if (hipMemsetAsync((char*)d_ws + WS_BAR, 0, 114688 + 256, stream) != hipSuccess) { fprintf(stderr, "kernel_launch: memset of the barrier words failed\n"); return; }
#if MK_N_LAUNCHES == 1
    a.ph_lo = 0; a.ph_hi = NPHASE;
    hipLaunchKernelGGL(hybrid_fwd, dim3(grid), dim3(NTHREADS), LDS_BYTES, stream, a);
#else
    for (int p = 0; p < NPHASE; ++p) {
        a.ph_lo = p; a.ph_hi = p + 1;
        hipLaunchKernelGGL(hybrid_fwd, dim3(grid), dim3(NTHREADS), LDS_BYTES, stream, a);
        if (p == PROBE_REPEAT) hipLaunchKernelGGL(hybrid_fwd, dim3(grid), dim3(NTHREADS), LDS_BYTES, stream, a);
    }
#endif
}
```
